# Optimizing an MI355X kernel written in HIP

```python
import jax, jax.numpy as jnp
from jax import lax
import numpy as np

D_MODEL = 1024
BATCH = 8
SEQ = 4096
DEPTH = 1

EPS = 1e-6
HG_HEADS = 8
HG_DK = 128
HG_DV = 128
HG_KW = HG_HEADS * HG_DK
HG_WIDTH = HG_HEADS * HG_DV
HG_CHUNK = 64
M2_HEADDIM = 64
M2_WIDTH = D_MODEL
M2_HEADS = M2_WIDTH // M2_HEADDIM
M2_GROUPS = 2
M2_STATE = 128
M2_CONV = 4
M2_CHUNK = 128
M2_CONV_DIM = M2_WIDTH + 2 * M2_GROUPS * M2_STATE
MIX_WIDTH = HG_WIDTH + M2_WIDTH
IN_COLS = 2 * HG_KW + 2 * HG_WIDTH + M2_WIDTH + M2_CONV_DIM + M2_HEADS

kernel_name = "hymba_style_hgrn2_mamba2_hybrid"


def rmsnorm(x, w):
    xf = x.astype(jnp.float32)
    y = xf * lax.rsqrt(jnp.mean(xf * xf, axis=-1, keepdims=True) + EPS)
    return (y * w.astype(jnp.float32)).astype(x.dtype)


def hgrn2_mix(q_raw, f_raw, i_raw, g_raw, lb, norm_w):
    B_, L, _ = q_raw.shape
    C = HG_CHUNK
    n = L // C
    lbf = lb.astype(jnp.float32)
    fl = f_raw.astype(jnp.float32)
    q = jax.nn.silu(q_raw.astype(jnp.float32))
    f = lbf + (1.0 - lbf) * jax.nn.sigmoid(fl)
    k = (1.0 - lbf) * jax.nn.sigmoid(-fl)
    logf = jnp.log(f)
    v = i_raw.astype(jnp.float32)

    def to_chunks(t, d):
        return t.reshape(B_, n, C, HG_HEADS, d).transpose(1, 0, 3, 2, 4)

    mask = jnp.tril(jnp.ones((C, C), dtype=bool))

    def step(S, inp):
        qc, kc, vc, gc = inp
        b = jnp.cumsum(gc, axis=2)
        o_inter = jnp.einsum('bhtk,bhkv->bhtv', qc * jnp.exp(b), S)
        diff = b[:, :, :, None, :] - b[:, :, None, :, :]
        decay = jnp.exp(jnp.where(mask[:, :, None], diff, -jnp.inf))
        att = jnp.einsum('bhtk,bhsk,bhtsk->bhts', qc, kc, decay)
        o_intra = jnp.einsum('bhts,bhsv->bhtv', att, vc)
        b_last = b[:, :, -1:, :]
        S_new = jnp.exp(b_last[:, :, 0, :])[..., None] * S + jnp.einsum(
            'bhsk,bhsv->bhkv', kc * jnp.exp(b_last - b), vc)
        return S_new, o_inter + o_intra

    S0 = jnp.zeros((B_, HG_HEADS, HG_DK, HG_DV), jnp.float32)
    _, o = lax.scan(step, S0, (to_chunks(q, HG_DK), to_chunks(k, HG_DK),
                               to_chunks(v, HG_DV), to_chunks(logf, HG_DK)))
    o = o.transpose(1, 0, 3, 2, 4).reshape(B_, L, HG_HEADS, HG_DV)
    o = o * lax.rsqrt(jnp.mean(o * o, axis=-1, keepdims=True) + EPS)
    o = o * norm_w.astype(jnp.float32).reshape(HG_HEADS, HG_DV)
    o = o.reshape(B_, L, HG_WIDTH) * jax.nn.silu(g_raw.astype(jnp.float32))
    return o.astype(q_raw.dtype)


def causal_dwconv(u, w, b):
    ch = u.shape[-1]
    out = lax.conv_general_dilated(
        u, w[:, None, :].astype(u.dtype), window_strides=(1,),
        padding=[(M2_CONV - 1, 0)], dimension_numbers=('NWC', 'WIO', 'NWC'),
        feature_group_count=ch)
    return out + b.astype(u.dtype)


def ssd_scan(x, dt, A, Bm, Cm):
    B_, L, H, P = x.shape
    C = M2_CHUNK
    n = L // C
    G = M2_GROUPS
    hg = H // G
    N = M2_STATE
    xc = x.reshape(B_, n, C, G, hg, P).transpose(1, 0, 3, 4, 2, 5)
    dtc = dt.reshape(B_, n, C, G, hg).transpose(1, 0, 3, 4, 2)
    ac = dtc * A.reshape(G, hg)[None, None, :, :, None]
    Bc = Bm.reshape(B_, n, C, G, N).transpose(1, 0, 3, 2, 4)
    Cc = Cm.reshape(B_, n, C, G, N).transpose(1, 0, 3, 2, 4)
    mask = jnp.tril(jnp.ones((C, C), dtype=bool))

    def step(state, inp):
        xk, dtk, ak, bk, ck = inp
        cs = jnp.cumsum(ak, axis=-1)
        seg = cs[..., :, None] - cs[..., None, :]
        Lmat = jnp.exp(jnp.where(mask, seg, -jnp.inf))
        cb = jnp.einsum('bgtn,bgsn->bgts', ck, bk)
        w = cb[:, :, None] * Lmat * dtk[..., None, :]
        y_diag = jnp.einsum('bghts,bghsp->bghtp', w, xk)
        y_off = jnp.einsum('bgtn,bghpn->bghtp', ck, state) * jnp.exp(cs)[..., None]
        decay_s = jnp.exp(cs[..., -1:] - cs) * dtk
        state_new = jnp.exp(cs[..., -1])[..., None, None] * state + jnp.einsum(
            'bghs,bghsp,bgsn->bghpn', decay_s, xk, bk)
        return state_new, y_diag + y_off

    s0 = jnp.zeros((B_, G, hg, P, N), jnp.float32)
    _, y = lax.scan(step, s0, (xc, dtc, ac, Bc, Cc))
    return y.transpose(1, 0, 4, 2, 3, 5).reshape(B_, L, H, P)


def mamba2_mix(z, xbc, dt_raw, conv_w, conv_b, dt_bias, a_log, d_skip, norm_w):
    B_, L, _ = z.shape
    xbc = jax.nn.silu(causal_dwconv(xbc, conv_w, conv_b)).astype(jnp.float32)
    xs = xbc[..., :M2_WIDTH].reshape(B_, L, M2_HEADS, M2_HEADDIM)
    Bm = xbc[..., M2_WIDTH:M2_WIDTH + M2_GROUPS * M2_STATE].reshape(B_, L, M2_GROUPS, M2_STATE)
    Cm = xbc[..., M2_WIDTH + M2_GROUPS * M2_STATE:].reshape(B_, L, M2_GROUPS, M2_STATE)
    dt = jax.nn.softplus(dt_raw.astype(jnp.float32) + dt_bias.astype(jnp.float32))
    A = -jnp.exp(a_log.astype(jnp.float32))
    y = ssd_scan(xs, dt, A, Bm, Cm) + d_skip.astype(jnp.float32)[:, None] * xs
    y = y.reshape(B_, L, M2_WIDTH) * jax.nn.silu(z.astype(jnp.float32))
    y = y.reshape(B_, L, M2_GROUPS, M2_WIDTH // M2_GROUPS)
    y = y * lax.rsqrt(jnp.mean(y * y, axis=-1, keepdims=True) + EPS)
    y = y.reshape(B_, L, M2_WIDTH) * norm_w.astype(jnp.float32)
    return y.astype(z.dtype)


def setup_inputs(seed: int = 0) -> dict:
    key = jax.random.key(seed)
    ks = jax.random.split(key, 16)
    f32 = jnp.float32
    x = jax.random.normal(ks[0], (BATCH, SEQ, D_MODEL), f32)
    norm_w = 1.0 + 0.02 * jax.random.normal(ks[1], (DEPTH, D_MODEL), f32)
    w_in = jax.random.normal(ks[2], (DEPTH, D_MODEL, IN_COLS), f32) * D_MODEL ** -0.5
    hg_lb_logits = 0.1 * jax.random.normal(ks[3], (DEPTH + 1, HG_KW), f32)
    hg_norm_w = 1.0 + 0.02 * jax.random.normal(ks[4], (DEPTH, HG_WIDTH), f32)
    m2_conv_w = jax.random.uniform(ks[5], (DEPTH, M2_CONV, M2_CONV_DIM), f32, -1.0, 1.0) * M2_CONV ** -0.5
    m2_conv_b = 0.02 * jax.random.normal(ks[6], (DEPTH, M2_CONV_DIM), f32)
    dt0 = jnp.exp(jax.random.uniform(ks[7], (DEPTH, M2_HEADS), f32, np.log(1e-3), np.log(1e-1)))
    m2_dt_bias = dt0 + jnp.log(-jnp.expm1(-dt0))
    m2_a_log = jnp.log(jax.random.uniform(ks[8], (DEPTH, M2_HEADS), f32, 1.0, 16.0))
    m2_d_skip = 1.0 + 0.02 * jax.random.normal(ks[9], (DEPTH, M2_HEADS), f32)
    m2_norm_w = 1.0 + 0.02 * jax.random.normal(ks[10], (DEPTH, M2_WIDTH), f32)
    w_out = jax.random.normal(ks[11], (DEPTH, MIX_WIDTH, D_MODEL), f32) * MIX_WIDTH ** -0.5
    final_norm_w = 1.0 + 0.02 * jax.random.normal(ks[12], (D_MODEL,), f32)
    return {"x": x, "norm_w": norm_w, "w_in": w_in, "hg_lb_logits": hg_lb_logits,
            "hg_norm_w": hg_norm_w, "m2_conv_w": m2_conv_w, "m2_conv_b": m2_conv_b,
            "m2_dt_bias": m2_dt_bias, "m2_a_log": m2_a_log, "m2_d_skip": m2_d_skip,
            "m2_norm_w": m2_norm_w, "w_out": w_out, "final_norm_w": final_norm_w}


def reference(x, norm_w, w_in, hg_lb_logits, hg_norm_w, m2_conv_w, m2_conv_b,
              m2_dt_bias, m2_a_log, m2_d_skip, m2_norm_w, w_out, final_norm_w):
    lb_all = jnp.cumsum(jax.nn.softmax(hg_lb_logits.astype(jnp.float32), axis=0), axis=0)
    sizes = [HG_KW, HG_KW, HG_WIDTH, HG_WIDTH, M2_WIDTH, M2_CONV_DIM, M2_HEADS]
    split_idx = [int(s) for s in np.cumsum(sizes)[:-1]]
    for l in range(DEPTH):
        h = rmsnorm(x, norm_w[l])
        proj = jnp.einsum('bsd,de->bse', h, w_in[l])
        q_raw, f_raw, i_raw, g_raw, z, xbc, dt_raw = jnp.split(proj, split_idx, axis=-1)
        hg_out = hgrn2_mix(q_raw, f_raw, i_raw, g_raw, lb_all[l], hg_norm_w[l])
        m2_out = mamba2_mix(z, xbc, dt_raw, m2_conv_w[l], m2_conv_b[l], m2_dt_bias[l],
                            m2_a_log[l], m2_d_skip[l], m2_norm_w[l])
        mix = jnp.concatenate([hg_out, m2_out], axis=-1)
        x = x + jnp.einsum('bse,ed->bsd', mix, w_out[l]).astype(x.dtype)
    return rmsnorm(x, final_norm_w)
```

```cpp
#include <hip/hip_runtime.h>
#include <hip/hip_cooperative_groups.h>
#include <cstdio>
namespace cg = cooperative_groups;

typedef unsigned short u16;
typedef short bf16x8 __attribute__((ext_vector_type(8)));
typedef float f32x4 __attribute__((ext_vector_type(4)));

constexpr int kT = 32768, kL = 4096;
constexpr int kNP = 6656;
constexpr int kNIN = 6672;
constexpr float kEps = 1e-6f;

__device__ __forceinline__ u16 f2bf(float f) { unsigned u = __float_as_uint(f); u += 0x7FFFu + ((u >> 16) & 1u); return (u16)(u >> 16); }
__device__ __forceinline__ float bf2f(u16 b) { return __uint_as_float(((unsigned)b) << 16); }
__device__ __forceinline__ u16 f2h(float f) { _Float16 h = (_Float16)f; return __builtin_bit_cast(u16, h); }
__device__ __forceinline__ float h2f(u16 b) { return (float)__builtin_bit_cast(_Float16, b); }
__device__ __forceinline__ float siluf(float v) { return v / (1.f + __expf(-v)); }
__device__ __forceinline__ float sigmf(float v) { return 1.f / (1.f + __expf(-v)); }
__device__ __forceinline__ float wave_sum(float v) {
#pragma unroll
  for (int o = 32; o >= 1; o >>= 1) v += __shfl_xor(v, o);
  return v;
}

struct Params {
  const float* x; const float* norm_w; const float* w_in; const float* lb_logits; const float* hg_nw;
  const float* conv_w; const float* conv_b; const float* dt_bias; const float* a_log; const float* d_skip;
  const float* m2_nw; const float* w_out; const float* fin_w;
  float* out;
  u16* h; u16* Wt1; u16* Wt2; u16* proj; float* dt; u16* mix; float* lb; float* xres;
};

__device__ void transpose_cvt(const float* src, int K, int N, u16* dst, float* tile  ) {
  const int tid = threadIdx.x;
  const int nk = K / 32, nn = (N + 31) / 32;
  for (int t = blockIdx.x; t < nk * nn; t += gridDim.x) {
    const int tk = t % nk, tn = t / nk;
    for (int i = tid; i < 1024; i += blockDim.x) { const int r = i >> 5, c = i & 31; const int n = tn * 32 + c;
      tile[r * 33 + c] = (n < N) ? src[(size_t)(tk * 32 + r) * N + n] : 0.f; }
    __syncthreads();
    for (int i = tid; i < 1024; i += blockDim.x) { const int r = i >> 5, c = i & 31; const int n = tn * 32 + r;
      if (n < N) dst[(size_t)n * K + tk * 32 + c] = f2bf(tile[c * 33 + r]); }
    __syncthreads();
  }
}

__device__ void phase_prep(const Params& p, char* smem) {
  const int tid = threadIdx.x, lane = tid & 63, wid = tid >> 6;
  const int gt = blockIdx.x * blockDim.x + tid;
  if (gt < 1024) { const float l0 = p.lb_logits[gt], l1 = p.lb_logits[1024 + gt]; p.lb[gt] = 1.f / (1.f + expf(l1 - l0)); }
  transpose_cvt(p.w_in, 1024, kNIN, p.Wt1, (float*)smem);
  transpose_cvt(p.w_out, 2048, 1024, p.Wt2, (float*)smem);
  const int gw = blockIdx.x * (blockDim.x >> 6) + wid, GW = gridDim.x * (blockDim.x >> 6);
  for (int row = gw; row < kT; row += GW) {
    const float4* xr = (const float4*)(p.x + (size_t)row * 1024);
    float4 v[4]; float ss = 0.f;
#pragma unroll
    for (int i = 0; i < 4; ++i) { v[i] = xr[i * 64 + lane]; ss += v[i].x * v[i].x + v[i].y * v[i].y + v[i].z * v[i].z + v[i].w * v[i].w; }
    ss = wave_sum(ss);
    const float rs = rsqrtf(ss * (1.f / 1024.f) + kEps);
#pragma unroll
    for (int i = 0; i < 4; ++i) { const float4 w = ((const float4*)p.norm_w)[i * 64 + lane];
      uint2 o; o.x = (unsigned)f2bf(v[i].x * rs * w.x) | ((unsigned)f2bf(v[i].y * rs * w.y) << 16);
      o.y = (unsigned)f2bf(v[i].z * rs * w.z) | ((unsigned)f2bf(v[i].w * rs * w.w) << 16);
      *(uint2*)(p.h + (size_t)row * 1024 + (i * 64 + lane) * 4) = o; }
  }
}

__device__ __forceinline__ u16 xform1(int c, float v, const float* lb) {
  if (c < 1024) return f2bf(siluf(v));
  if (c < 2048) { const float l = lb[c - 1024]; const float f = l + (1.f - l) * sigmf(v); return f2h(logf(f)); }
  if (c < 3072) return f2bf(v);
  if (c < 5120) return f2bf(siluf(v));
  return f2bf(v);
}
struct Epi1 { u16* proj; const float* lb;
  __device__ __forceinline__ void operator()(int r, int c, float v) const { proj[(size_t)r * kNP + c] = xform1(c, v, lb); } };
struct Epi2 { float* xres; const float* x;
  __device__ __forceinline__ void operator()(int r, int c, float v) const { xres[(size_t)r * 1024 + c] = x[(size_t)r * 1024 + c] + v; } };

template <class Epi>
__device__ void gemm_naive(const u16* A, const u16* Bt, int M, int N, int K, const Epi& epi) {
  const int tid = threadIdx.x, lane = tid & 63, wid = tid >> 6, fr = lane & 15, fq = lane >> 4;
  const int gw = blockIdx.x * (blockDim.x >> 6) + wid, GW = gridDim.x * (blockDim.x >> 6);
  const int nN = N / 32, ntile = (M / 32) * nN;
  for (int t = gw; t < ntile; t += GW) {
    const int m0 = (t / nN) * 32, n0 = (t % nN) * 32;
    f32x4 acc[2][2];
#pragma unroll
    for (int i = 0; i < 2; ++i)
#pragma unroll
      for (int j = 0; j < 2; ++j) acc[i][j] = (f32x4){0.f, 0.f, 0.f, 0.f};
    for (int k0 = 0; k0 < K; k0 += 32) {
      bf16x8 a[2], b[2];
#pragma unroll
      for (int i = 0; i < 2; ++i) a[i] = *(const bf16x8*)(A + (size_t)(m0 + i * 16 + fr) * K + k0 + fq * 8);
#pragma unroll
      for (int j = 0; j < 2; ++j) b[j] = *(const bf16x8*)(Bt + (size_t)(n0 + j * 16 + fr) * K + k0 + fq * 8);
#pragma unroll
      for (int i = 0; i < 2; ++i)
#pragma unroll
        for (int j = 0; j < 2; ++j) acc[i][j] = __builtin_amdgcn_mfma_f32_16x16x32_bf16(a[i], b[j], acc[i][j], 0, 0, 0);
    }
#pragma unroll
    for (int i = 0; i < 2; ++i)
#pragma unroll
      for (int j = 0; j < 2; ++j)
#pragma unroll
        for (int r = 0; r < 4; ++r) epi(m0 + i * 16 + fq * 4 + r, n0 + j * 16 + fr, acc[i][j][r]);
  }
}

__device__ void phase_dt(const Params& p) {
  const int tid = threadIdx.x, lane = tid & 63, wid = tid >> 6, fr = lane & 15, fq = lane >> 4;
  const int gw = blockIdx.x * (blockDim.x >> 6) + wid, GW = gridDim.x * (blockDim.x >> 6);
  for (int t = gw; t < kT / 16; t += GW) {
    const int m0 = t * 16;
    f32x4 acc = (f32x4){0.f, 0.f, 0.f, 0.f};
    for (int k0 = 0; k0 < 1024; k0 += 32) {
      const bf16x8 a = *(const bf16x8*)(p.h + (size_t)(m0 + fr) * 1024 + k0 + fq * 8);
      const bf16x8 b = *(const bf16x8*)(p.Wt1 + (size_t)(kNP + fr) * 1024 + k0 + fq * 8);
      acc = __builtin_amdgcn_mfma_f32_16x16x32_bf16(a, b, acc, 0, 0, 0);
    }
    const float bias = p.dt_bias[fr];
#pragma unroll
    for (int r = 0; r < 4; ++r) { const float v = acc[r] + bias; const float sp = v > 20.f ? v : log1pf(expf(v));
      p.dt[(size_t)(m0 + fq * 4 + r) * 16 + fr] = sp; }
  }
}

__device__ void hgrn2_naive(const Params& p, int unit, char* smem) {
  const int b = unit >> 3, hh = unit & 7;
  const int tid = threadIdx.x, v = tid & 127, kq = tid >> 7;
  float S[32];
#pragma unroll
  for (int i = 0; i < 32; ++i) S[i] = 0.f;
  float* sq = (float*)smem; float* sf = sq + 2048; float* sk = sf + 2048; float* sv = sk + 2048; float* sp = sv + 2048;
  for (int t0 = 0; t0 < kL; t0 += 16) {
    for (int i = tid; i < 2048; i += 512) { const int tt = i >> 7, c = i & 127; const size_t row = (size_t)(b * kL + t0 + tt) * kNP;
      sq[i] = bf2f(p.proj[row + hh * 128 + c]);
      const float f = __expf(h2f(p.proj[row + 1024 + hh * 128 + c])); sf[i] = f; sk[i] = 1.f - f;
      sv[i] = bf2f(p.proj[row + 2048 + hh * 128 + c]); }
    __syncthreads();
    for (int tt = 0; tt < 16; ++tt) { const float vv = sv[tt * 128 + v]; float acc = 0.f;
#pragma unroll
      for (int i = 0; i < 32; ++i) { const int k = kq * 32 + i; S[i] = sf[tt * 128 + k] * S[i] + sk[tt * 128 + k] * vv; acc += S[i] * sq[tt * 128 + k]; }
      sp[(kq * 16 + tt) * 128 + v] = acc; }
    __syncthreads();
    { const int tt = tid >> 5, l32 = tid & 31; float o[4]; float ss = 0.f;
#pragma unroll
      for (int j = 0; j < 4; ++j) { const int vv = l32 + 32 * j; o[j] = sp[(0 * 16 + tt) * 128 + vv] + sp[(1 * 16 + tt) * 128 + vv] + sp[(2 * 16 + tt) * 128 + vv] + sp[(3 * 16 + tt) * 128 + vv]; ss += o[j] * o[j]; }
#pragma unroll
      for (int off = 16; off >= 1; off >>= 1) ss += __shfl_xor(ss, off);
      const float rs = rsqrtf(ss * (1.f / 128.f) + kEps);
      const size_t row = (size_t)(b * kL + t0 + tt);
#pragma unroll
      for (int j = 0; j < 4; ++j) { const int vv = l32 + 32 * j; const float g = bf2f(p.proj[row * kNP + 3072 + hh * 128 + vv]);
        p.mix[row * 2048 + hh * 128 + vv] = f2bf(o[j] * rs * p.hg_nw[hh * 128 + vv] * g); } }
  }
}

__device__ void mamba2_naive(const Params& p, int unit, char* smem) {
  const int b = unit >> 4, hd = unit & 15, g = hd >> 3;
  const int tid = threadIdx.x, pp = tid & 63, nq = tid >> 6;
  float st[16];
#pragma unroll
  for (int i = 0; i < 16; ++i) st[i] = 0.f;
  const float A = -__expf(p.a_log[hd]), Dk = p.d_skip[hd];
  float* sx = (float*)smem; float* sB = sx + 16 * 64; float* sC = sB + 16 * 128; float* sdt = sC + 16 * 128; float* sp = sdt + 16;
  for (int t0 = 0; t0 < kL; t0 += 16) {
    for (int i = tid; i < 5120; i += 512) { const int tt = i / 320, c = i % 320;
      const int ch = c < 64 ? hd * 64 + c : (c < 192 ? 1024 + g * 128 + (c - 64) : 1280 + g * 128 + (c - 192));
      float acc = p.conv_b[ch];
#pragma unroll
      for (int j = 0; j < 4; ++j) { const int ts = t0 + tt - 3 + j; if (ts >= 0) acc += p.conv_w[j * 1536 + ch] * bf2f(p.proj[(size_t)(b * kL + ts) * kNP + 5120 + ch]); }
      acc = siluf(acc);
      if (c < 64) sx[tt * 64 + c] = acc; else if (c < 192) sB[tt * 128 + c - 64] = acc; else sC[tt * 128 + c - 192] = acc; }
    if (tid < 16) sdt[tid] = p.dt[(size_t)(b * kL + t0 + tid) * 16 + hd];
    __syncthreads();
    for (int tt = 0; tt < 16; ++tt) { const float dt = sdt[tt], dA = __expf(dt * A), dx = dt * sx[tt * 64 + pp]; float acc = 0.f;
#pragma unroll
      for (int i = 0; i < 16; ++i) { const int n = nq * 16 + i; st[i] = dA * st[i] + dx * sB[tt * 128 + n]; acc += st[i] * sC[tt * 128 + n]; }
      sp[(nq * 16 + tt) * 64 + pp] = acc; }
    __syncthreads();
    for (int i = tid; i < 1024; i += 512) { const int tt = i >> 6, q = i & 63; float y = Dk * sx[tt * 64 + q];
#pragma unroll
      for (int r = 0; r < 8; ++r) y += sp[(r * 16 + tt) * 64 + q];
      const size_t row = (size_t)(b * kL + t0 + tt); const float z = bf2f(p.proj[row * kNP + 4096 + hd * 64 + q]);
      p.mix[row * 2048 + 1024 + hd * 64 + q] = f2bf(y * z); }
    __syncthreads();
  }
}

__device__ void phase_m2norm(const Params& p) {
  const int tid = threadIdx.x, lane = tid & 63, wid = tid >> 6;
  const int gw = blockIdx.x * (blockDim.x >> 6) + wid, GW = gridDim.x * (blockDim.x >> 6);
  for (int it = gw; it < kT * 2; it += GW) {
    const int row = it >> 1, g = it & 1;
    u16* ptr = p.mix + (size_t)row * 2048 + 1024 + g * 512 + lane * 8;
    const uint4 raw = *(const uint4*)ptr; const unsigned rw[4] = {raw.x, raw.y, raw.z, raw.w};
    float v[8]; float ss = 0.f;
#pragma unroll
    for (int i = 0; i < 4; ++i) { v[2 * i] = __uint_as_float(rw[i] << 16); v[2 * i + 1] = __uint_as_float(rw[i] & 0xffff0000u); ss += v[2 * i] * v[2 * i] + v[2 * i + 1] * v[2 * i + 1]; }
    ss = wave_sum(ss);
    const float rs = rsqrtf(ss * (1.f / 512.f) + kEps);
    const float* nw = p.m2_nw + g * 512 + lane * 8;
    unsigned ow[4];
#pragma unroll
    for (int i = 0; i < 4; ++i) ow[i] = (unsigned)f2bf(v[2 * i] * rs * nw[2 * i]) | ((unsigned)f2bf(v[2 * i + 1] * rs * nw[2 * i + 1]) << 16);
    *(uint4*)ptr = make_uint4(ow[0], ow[1], ow[2], ow[3]);
  }
}

__device__ void phase_final(const Params& p) {
  const int tid = threadIdx.x, lane = tid & 63, wid = tid >> 6;
  const int gw = blockIdx.x * (blockDim.x >> 6) + wid, GW = gridDim.x * (blockDim.x >> 6);
  for (int row = gw; row < kT; row += GW) {
    const float4* xr = (const float4*)(p.xres + (size_t)row * 1024);
    float4 v[4]; float ss = 0.f;
#pragma unroll
    for (int i = 0; i < 4; ++i) { v[i] = xr[i * 64 + lane]; ss += v[i].x * v[i].x + v[i].y * v[i].y + v[i].z * v[i].z + v[i].w * v[i].w; }
    ss = wave_sum(ss);
    const float rs = rsqrtf(ss * (1.f / 1024.f) + kEps);
#pragma unroll
    for (int i = 0; i < 4; ++i) { const float4 w = ((const float4*)p.fin_w)[i * 64 + lane];
      float4 o; o.x = v[i].x * rs * w.x; o.y = v[i].y * rs * w.y; o.z = v[i].z * rs * w.z; o.w = v[i].w * rs * w.w;
      ((float4*)(p.out + (size_t)row * 1024))[i * 64 + lane] = o; }
  }
}

extern __shared__ __attribute__((aligned(16))) char g_smem[];
__global__ void __launch_bounds__(512) k_prep(Params p) { phase_prep(p, g_smem); }
__global__ void __launch_bounds__(512) k_gemm1(Params p) { Epi1 e{p.proj, p.lb}; gemm_naive(p.h, p.Wt1, kT, kNP, 1024, e); phase_dt(p); }
__global__ void __launch_bounds__(512) k_mix(Params p) {
  for (int u = blockIdx.x; u < 192; u += gridDim.x) { if (u < 64) hgrn2_naive(p, u, g_smem); else mamba2_naive(p, u - 64, g_smem); __syncthreads(); }
}
__global__ void __launch_bounds__(512) k_m2norm(Params p) { phase_m2norm(p); }
__global__ void __launch_bounds__(512) k_gemm2(Params p) { Epi2 e{p.xres, p.x}; gemm_naive(p.mix, p.Wt2, kT, 1024, 2048, e); }
__global__ void __launch_bounds__(512) k_final(Params p) { phase_final(p); }

extern "C" void kernel_launch(void* const* d_in, const int* in_sizes, int n_in, void* d_out, int out_size, void* d_ws, size_t ws_size, hipStream_t stream) {
  Params p{};
  p.x = (const float*)d_in[0]; p.norm_w = (const float*)d_in[1]; p.w_in = (const float*)d_in[2]; p.lb_logits = (const float*)d_in[3];
  p.hg_nw = (const float*)d_in[4]; p.conv_w = (const float*)d_in[5]; p.conv_b = (const float*)d_in[6]; p.dt_bias = (const float*)d_in[7];
  p.a_log = (const float*)d_in[8]; p.d_skip = (const float*)d_in[9]; p.m2_nw = (const float*)d_in[10]; p.w_out = (const float*)d_in[11];
  p.fin_w = (const float*)d_in[12];
  p.out = (float*)d_out;
  char* ws = (char*)d_ws; size_t off = 0;
  auto take = [&](size_t bytes) { char* r = ws + off; off += (bytes + 255) & ~(size_t)255; return r; };
  p.proj = (u16*)take((size_t)kT * kNP * 2);
  p.xres = (float*)p.proj;
  p.Wt1 = (u16*)take((size_t)kNIN * 1024 * 2);
  p.Wt2 = (u16*)take((size_t)1024 * 2048 * 2);
  p.dt = (float*)take((size_t)kT * 16 * 4);
  p.lb = (float*)take(1024 * 4);
  p.h = (u16*)d_out;
  p.mix = (u16*)d_out;
  if (off > ws_size) { fprintf(stderr, "workspace too small: need %zu have %zu\n", off, ws_size); return; }
  const int grid = 1024;
  k_prep<<<grid, 512, 8192, stream>>>(p);
  k_gemm1<<<grid, 512, 0, stream>>>(p);
  k_mix<<<192, 512, 65536, stream>>>(p);
  k_m2norm<<<grid, 512, 0, stream>>>(p);
  k_gemm2<<<grid, 512, 0, stream>>>(p);
  k_final<<<grid, 512, 0, stream>>>(p);
}
```

```cpp
#include <hip/hip_runtime.h>
#include <hip/hip_cooperative_groups.h>
#include <cstdio>
namespace cg = cooperative_groups;

typedef unsigned short u16;
typedef short bf16x8 __attribute__((ext_vector_type(8)));
typedef float f32x4 __attribute__((ext_vector_type(4)));

constexpr int kT = 32768, kL = 4096;
constexpr int kNP = 6656;
constexpr int kNIN = 6672;
constexpr float kEps = 1e-6f;

__device__ __forceinline__ u16 f2bf(float f) { unsigned u = __float_as_uint(f); u += 0x7FFFu + ((u >> 16) & 1u); return (u16)(u >> 16); }
__device__ __forceinline__ float bf2f(u16 b) { return __uint_as_float(((unsigned)b) << 16); }
__device__ __forceinline__ u16 f2h(float f) { _Float16 h = (_Float16)f; return __builtin_bit_cast(u16, h); }
__device__ __forceinline__ float h2f(u16 b) { return (float)__builtin_bit_cast(_Float16, b); }
__device__ __forceinline__ float siluf(float v) { return v / (1.f + __expf(-v)); }
__device__ __forceinline__ float sigmf(float v) { return 1.f / (1.f + __expf(-v)); }
__device__ __forceinline__ float wave_sum(float v) {
#pragma unroll
  for (int o = 32; o >= 1; o >>= 1) v += __shfl_xor(v, o);
  return v;
}

struct Params {
  const float* x; const float* norm_w; const float* w_in; const float* lb_logits; const float* hg_nw;
  const float* conv_w; const float* conv_b; const float* dt_bias; const float* a_log; const float* d_skip;
  const float* m2_nw; const float* w_out; const float* fin_w;
  float* out;
  u16* h; u16* Wt1; u16* Wt2; u16* proj; float* dt; u16* mix; float* lb; float* xres;
};

__device__ void transpose_cvt(const float* src, int K, int N, u16* dst, float* tile  ) {
  const int tid = threadIdx.x;
  const int nk = K / 32, nn = (N + 31) / 32;
  for (int t = blockIdx.x; t < nk * nn; t += gridDim.x) {
    const int tk = t % nk, tn = t / nk;
    for (int i = tid; i < 1024; i += blockDim.x) { const int r = i >> 5, c = i & 31; const int n = tn * 32 + c;
      tile[r * 33 + c] = (n < N) ? src[(size_t)(tk * 32 + r) * N + n] : 0.f; }
    __syncthreads();
    for (int i = tid; i < 1024; i += blockDim.x) { const int r = i >> 5, c = i & 31; const int n = tn * 32 + r;
      if (n < N) dst[(size_t)n * K + tk * 32 + c] = f2bf(tile[c * 33 + r]); }
    __syncthreads();
  }
}

__device__ void phase_prep(const Params& p, char* smem) {
  const int tid = threadIdx.x, lane = tid & 63, wid = tid >> 6;
  const int gt = blockIdx.x * blockDim.x + tid;
  if (gt < 1024) { const float l0 = p.lb_logits[gt], l1 = p.lb_logits[1024 + gt]; p.lb[gt] = 1.f / (1.f + expf(l1 - l0)); }
  transpose_cvt(p.w_in, 1024, kNIN, p.Wt1, (float*)smem);
  transpose_cvt(p.w_out, 2048, 1024, p.Wt2, (float*)smem);
  const int gw = blockIdx.x * (blockDim.x >> 6) + wid, GW = gridDim.x * (blockDim.x >> 6);
  for (int row = gw; row < kT; row += GW) {
    const float4* xr = (const float4*)(p.x + (size_t)row * 1024);
    float4 v[4]; float ss = 0.f;
#pragma unroll
    for (int i = 0; i < 4; ++i) { v[i] = xr[i * 64 + lane]; ss += v[i].x * v[i].x + v[i].y * v[i].y + v[i].z * v[i].z + v[i].w * v[i].w; }
    ss = wave_sum(ss);
    const float rs = rsqrtf(ss * (1.f / 1024.f) + kEps);
#pragma unroll
    for (int i = 0; i < 4; ++i) { const float4 w = ((const float4*)p.norm_w)[i * 64 + lane];
      uint2 o; o.x = (unsigned)f2bf(v[i].x * rs * w.x) | ((unsigned)f2bf(v[i].y * rs * w.y) << 16);
      o.y = (unsigned)f2bf(v[i].z * rs * w.z) | ((unsigned)f2bf(v[i].w * rs * w.w) << 16);
      *(uint2*)(p.h + (size_t)row * 1024 + (i * 64 + lane) * 4) = o; }
  }
}

__device__ __forceinline__ u16 xform1(int c, float v, const float* lb) {
  if (c < 1024) return f2bf(siluf(v));
  if (c < 2048) { const float l = lb[c - 1024]; const float f = l + (1.f - l) * sigmf(v); return f2h(logf(f)); }
  if (c < 3072) return f2bf(v);
  if (c < 5120) return f2bf(siluf(v));
  return f2bf(v);
}
struct Epi1 { u16* proj; const float* lb;
  __device__ __forceinline__ void operator()(int r, int c, float v) const { proj[(size_t)r * kNP + c] = xform1(c, v, lb); } };
struct Epi2 { float* xres; const float* x;
  __device__ __forceinline__ void operator()(int r, int c, float v) const { xres[(size_t)r * 1024 + c] = x[(size_t)r * 1024 + c] + v; } };

template <class Epi>
__device__ void gemm_naive(const u16* A, const u16* Bt, int M, int N, int K, const Epi& epi) {
  const int tid = threadIdx.x, lane = tid & 63, wid = tid >> 6, fr = lane & 15, fq = lane >> 4;
  const int gw = blockIdx.x * (blockDim.x >> 6) + wid, GW = gridDim.x * (blockDim.x >> 6);
  const int nN = N / 32, ntile = (M / 32) * nN;
  for (int t = gw; t < ntile; t += GW) {
    const int m0 = (t / nN) * 32, n0 = (t % nN) * 32;
    f32x4 acc[2][2];
#pragma unroll
    for (int i = 0; i < 2; ++i)
#pragma unroll
      for (int j = 0; j < 2; ++j) acc[i][j] = (f32x4){0.f, 0.f, 0.f, 0.f};
    for (int k0 = 0; k0 < K; k0 += 32) {
      bf16x8 a[2], b[2];
#pragma unroll
      for (int i = 0; i < 2; ++i) a[i] = *(const bf16x8*)(A + (size_t)(m0 + i * 16 + fr) * K + k0 + fq * 8);
#pragma unroll
      for (int j = 0; j < 2; ++j) b[j] = *(const bf16x8*)(Bt + (size_t)(n0 + j * 16 + fr) * K + k0 + fq * 8);
#pragma unroll
      for (int i = 0; i < 2; ++i)
#pragma unroll
        for (int j = 0; j < 2; ++j) acc[i][j] = __builtin_amdgcn_mfma_f32_16x16x32_bf16(a[i], b[j], acc[i][j], 0, 0, 0);
    }
#pragma unroll
    for (int i = 0; i < 2; ++i)
#pragma unroll
      for (int j = 0; j < 2; ++j)
#pragma unroll
        for (int r = 0; r < 4; ++r) epi(m0 + i * 16 + fq * 4 + r, n0 + j * 16 + fr, acc[i][j][r]);
  }
}

__device__ void phase_dt(const Params& p) {
  const int tid = threadIdx.x, lane = tid & 63, wid = tid >> 6, fr = lane & 15, fq = lane >> 4;
  const int gw = blockIdx.x * (blockDim.x >> 6) + wid, GW = gridDim.x * (blockDim.x >> 6);
  for (int t = gw; t < kT / 16; t += GW) {
    const int m0 = t * 16;
    f32x4 acc = (f32x4){0.f, 0.f, 0.f, 0.f};
    for (int k0 = 0; k0 < 1024; k0 += 32) {
      const bf16x8 a = *(const bf16x8*)(p.h + (size_t)(m0 + fr) * 1024 + k0 + fq * 8);
      const bf16x8 b = *(const bf16x8*)(p.Wt1 + (size_t)(kNP + fr) * 1024 + k0 + fq * 8);
      acc = __builtin_amdgcn_mfma_f32_16x16x32_bf16(a, b, acc, 0, 0, 0);
    }
    const float bias = p.dt_bias[fr];
#pragma unroll
    for (int r = 0; r < 4; ++r) { const float v = acc[r] + bias; const float sp = v > 20.f ? v : log1pf(expf(v));
      p.dt[(size_t)(m0 + fq * 4 + r) * 16 + fr] = sp; }
  }
}

__device__ void hgrn2_naive(const Params& p, int unit, char* smem) {
  const int b = unit >> 3, hh = unit & 7;
  const int tid = threadIdx.x, v = tid & 127, kq = tid >> 7;
  float S[32];
#pragma unroll
  for (int i = 0; i < 32; ++i) S[i] = 0.f;
  float* sq = (float*)smem; float* sf = sq + 2048; float* sk = sf + 2048; float* sv = sk + 2048; float* sp = sv + 2048;
  for (int t0 = 0; t0 < kL; t0 += 16) {
    for (int i = tid; i < 2048; i += 512) { const int tt = i >> 7, c = i & 127; const size_t row = (size_t)(b * kL + t0 + tt) * kNP;
      sq[i] = bf2f(p.proj[row + hh * 128 + c]);
      const float f = __expf(h2f(p.proj[row + 1024 + hh * 128 + c])); sf[i] = f; sk[i] = 1.f - f;
      sv[i] = bf2f(p.proj[row + 2048 + hh * 128 + c]); }
    __syncthreads();
    for (int tt = 0; tt < 16; ++tt) { const float vv = sv[tt * 128 + v]; float acc = 0.f;
#pragma unroll
      for (int i = 0; i < 32; ++i) { const int k = kq * 32 + i; S[i] = sf[tt * 128 + k] * S[i] + sk[tt * 128 + k] * vv; acc += S[i] * sq[tt * 128 + k]; }
      sp[(kq * 16 + tt) * 128 + v] = acc; }
    __syncthreads();
    { const int tt = tid >> 5, l32 = tid & 31; float o[4]; float ss = 0.f;
#pragma unroll
      for (int j = 0; j < 4; ++j) { const int vv = l32 + 32 * j; o[j] = sp[(0 * 16 + tt) * 128 + vv] + sp[(1 * 16 + tt) * 128 + vv] + sp[(2 * 16 + tt) * 128 + vv] + sp[(3 * 16 + tt) * 128 + vv]; ss += o[j] * o[j]; }
#pragma unroll
      for (int off = 16; off >= 1; off >>= 1) ss += __shfl_xor(ss, off);
      const float rs = rsqrtf(ss * (1.f / 128.f) + kEps);
      const size_t row = (size_t)(b * kL + t0 + tt);
#pragma unroll
      for (int j = 0; j < 4; ++j) { const int vv = l32 + 32 * j; const float g = bf2f(p.proj[row * kNP + 3072 + hh * 128 + vv]);
        p.mix[row * 2048 + hh * 128 + vv] = f2bf(o[j] * rs * p.hg_nw[hh * 128 + vv] * g); } }
  }
}

__device__ void mamba2_naive(const Params& p, int unit, char* smem) {
  const int b = unit >> 4, hd = unit & 15, g = hd >> 3;
  const int tid = threadIdx.x, pp = tid & 63, nq = tid >> 6;
  float st[16];
#pragma unroll
  for (int i = 0; i < 16; ++i) st[i] = 0.f;
  const float A = -__expf(p.a_log[hd]), Dk = p.d_skip[hd];
  float* sx = (float*)smem; float* sB = sx + 16 * 64; float* sC = sB + 16 * 128; float* sdt = sC + 16 * 128; float* sp = sdt + 16;
  for (int t0 = 0; t0 < kL; t0 += 16) {
    for (int i = tid; i < 5120; i += 512) { const int tt = i / 320, c = i % 320;
      const int ch = c < 64 ? hd * 64 + c : (c < 192 ? 1024 + g * 128 + (c - 64) : 1280 + g * 128 + (c - 192));
      float acc = p.conv_b[ch];
#pragma unroll
      for (int j = 0; j < 4; ++j) { const int ts = t0 + tt - 3 + j; if (ts >= 0) acc += p.conv_w[j * 1536 + ch] * bf2f(p.proj[(size_t)(b * kL + ts) * kNP + 5120 + ch]); }
      acc = siluf(acc);
      if (c < 64) sx[tt * 64 + c] = acc; else if (c < 192) sB[tt * 128 + c - 64] = acc; else sC[tt * 128 + c - 192] = acc; }
    if (tid < 16) sdt[tid] = p.dt[(size_t)(b * kL + t0 + tid) * 16 + hd];
    __syncthreads();
    for (int tt = 0; tt < 16; ++tt) { const float dt = sdt[tt], dA = __expf(dt * A), dx = dt * sx[tt * 64 + pp]; float acc = 0.f;
#pragma unroll
      for (int i = 0; i < 16; ++i) { const int n = nq * 16 + i; st[i] = dA * st[i] + dx * sB[tt * 128 + n]; acc += st[i] * sC[tt * 128 + n]; }
      sp[(nq * 16 + tt) * 64 + pp] = acc; }
    __syncthreads();
    for (int i = tid; i < 1024; i += 512) { const int tt = i >> 6, q = i & 63; float y = Dk * sx[tt * 64 + q];
#pragma unroll
      for (int r = 0; r < 8; ++r) y += sp[(r * 16 + tt) * 64 + q];
      const size_t row = (size_t)(b * kL + t0 + tt); const float z = bf2f(p.proj[row * kNP + 4096 + hd * 64 + q]);
      p.mix[row * 2048 + 1024 + hd * 64 + q] = f2bf(y * z); }
    __syncthreads();
  }
}

__device__ void phase_m2norm(const Params& p) {
  const int tid = threadIdx.x, lane = tid & 63, wid = tid >> 6;
  const int gw = blockIdx.x * (blockDim.x >> 6) + wid, GW = gridDim.x * (blockDim.x >> 6);
  for (int it = gw; it < kT * 2; it += GW) {
    const int row = it >> 1, g = it & 1;
    u16* ptr = p.mix + (size_t)row * 2048 + 1024 + g * 512 + lane * 8;
    const uint4 raw = *(const uint4*)ptr; const unsigned rw[4] = {raw.x, raw.y, raw.z, raw.w};
    float v[8]; float ss = 0.f;
#pragma unroll
    for (int i = 0; i < 4; ++i) { v[2 * i] = __uint_as_float(rw[i] << 16); v[2 * i + 1] = __uint_as_float(rw[i] & 0xffff0000u); ss += v[2 * i] * v[2 * i] + v[2 * i + 1] * v[2 * i + 1]; }
    ss = wave_sum(ss);
    const float rs = rsqrtf(ss * (1.f / 512.f) + kEps);
    const float* nw = p.m2_nw + g * 512 + lane * 8;
    unsigned ow[4];
#pragma unroll
    for (int i = 0; i < 4; ++i) ow[i] = (unsigned)f2bf(v[2 * i] * rs * nw[2 * i]) | ((unsigned)f2bf(v[2 * i + 1] * rs * nw[2 * i + 1]) << 16);
    *(uint4*)ptr = make_uint4(ow[0], ow[1], ow[2], ow[3]);
  }
}

__device__ void phase_final(const Params& p) {
  const int tid = threadIdx.x, lane = tid & 63, wid = tid >> 6;
  const int gw = blockIdx.x * (blockDim.x >> 6) + wid, GW = gridDim.x * (blockDim.x >> 6);
  for (int row = gw; row < kT; row += GW) {
    const float4* xr = (const float4*)(p.xres + (size_t)row * 1024);
    float4 v[4]; float ss = 0.f;
#pragma unroll
    for (int i = 0; i < 4; ++i) { v[i] = xr[i * 64 + lane]; ss += v[i].x * v[i].x + v[i].y * v[i].y + v[i].z * v[i].z + v[i].w * v[i].w; }
    ss = wave_sum(ss);
    const float rs = rsqrtf(ss * (1.f / 1024.f) + kEps);
#pragma unroll
    for (int i = 0; i < 4; ++i) { const float4 w = ((const float4*)p.fin_w)[i * 64 + lane];
      float4 o; o.x = v[i].x * rs * w.x; o.y = v[i].y * rs * w.y; o.z = v[i].z * rs * w.z; o.w = v[i].w * rs * w.w;
      ((float4*)(p.out + (size_t)row * 1024))[i * 64 + lane] = o; }
  }
}

extern __shared__ __attribute__((aligned(16))) char g_smem[];
constexpr int kThreads = 512;
constexpr size_t kDynLds = 65536;
__global__ void __launch_bounds__(kThreads) k_mega(Params p) {
  cg::grid_group grid = cg::this_grid();
  phase_prep(p, g_smem);
  grid.sync();
  { Epi1 e{p.proj, p.lb}; gemm_naive(p.h, p.Wt1, kT, kNP, 1024, e); phase_dt(p); }
  grid.sync();
  for (int u = blockIdx.x; u < 192; u += gridDim.x) { if (u < 64) hgrn2_naive(p, u, g_smem); else mamba2_naive(p, u - 64, g_smem); __syncthreads(); }
  grid.sync();
  phase_m2norm(p);
  grid.sync();
  { Epi2 e{p.xres, p.x}; gemm_naive(p.mix, p.Wt2, kT, 1024, 2048, e); }
  grid.sync();
  phase_final(p);
}

extern "C" void kernel_launch(void* const* d_in, const int* in_sizes, int n_in, void* d_out, int out_size, void* d_ws, size_t ws_size, hipStream_t stream) {
  Params p{};
  p.x = (const float*)d_in[0]; p.norm_w = (const float*)d_in[1]; p.w_in = (const float*)d_in[2]; p.lb_logits = (const float*)d_in[3];
  p.hg_nw = (const float*)d_in[4]; p.conv_w = (const float*)d_in[5]; p.conv_b = (const float*)d_in[6]; p.dt_bias = (const float*)d_in[7];
  p.a_log = (const float*)d_in[8]; p.d_skip = (const float*)d_in[9]; p.m2_nw = (const float*)d_in[10]; p.w_out = (const float*)d_in[11];
  p.fin_w = (const float*)d_in[12];
  p.out = (float*)d_out;
  char* ws = (char*)d_ws; size_t off = 0;
  auto take = [&](size_t bytes) { char* r = ws + off; off += (bytes + 255) & ~(size_t)255; return r; };
  p.proj = (u16*)take((size_t)kT * kNP * 2);
  p.xres = (float*)p.proj;
  p.Wt1 = (u16*)take((size_t)kNIN * 1024 * 2);
  p.Wt2 = (u16*)take((size_t)1024 * 2048 * 2);
  p.dt = (float*)take((size_t)kT * 16 * 4);
  p.lb = (float*)take(1024 * 4);
  p.h = (u16*)d_out;
  p.mix = (u16*)d_out;
  if (off > ws_size) { fprintf(stderr, "workspace too small: need %zu have %zu\n", off, ws_size); return; }
  static int grid_blocks = 0;
  if (!grid_blocks) {
    int dev = 0, cus = 0, per_cu = 0;
    hipGetDevice(&dev);
    hipFuncSetAttribute((const void*)k_mega, hipFuncAttributeMaxDynamicSharedMemorySize, (int)kDynLds);
    hipDeviceGetAttribute(&cus, hipDeviceAttributeMultiprocessorCount, dev);
    hipOccupancyMaxActiveBlocksPerMultiprocessor(&per_cu, k_mega, kThreads, kDynLds);
    if (per_cu > 2) per_cu = 2;
    grid_blocks = cus * per_cu;
  }
  void* args[] = {&p};
  hipError_t e = hipLaunchCooperativeKernel((void*)k_mega, dim3(grid_blocks), dim3(kThreads), args, kDynLds, stream);
  if (e != hipSuccess) fprintf(stderr, "cooperative launch failed: %s (grid %d)\n", hipGetErrorString(e), grid_blocks);
}
```

```cpp
#include <hip/hip_runtime.h>
#include <hip/hip_cooperative_groups.h>
#include <cstdio>
namespace cg = cooperative_groups;

typedef unsigned short u16;
typedef short bf16x8 __attribute__((ext_vector_type(8)));
typedef float f32x4 __attribute__((ext_vector_type(4)));

constexpr int kT = 32768, kL = 4096;
constexpr int kNP = 6656;
constexpr int kNIN = 6672;
constexpr float kEps = 1e-6f;

__device__ __forceinline__ u16 f2bf(float f) { unsigned u = __float_as_uint(f); u += 0x7FFFu + ((u >> 16) & 1u); return (u16)(u >> 16); }
__device__ __forceinline__ float bf2f(u16 b) { return __uint_as_float(((unsigned)b) << 16); }
__device__ __forceinline__ u16 f2h(float f) { _Float16 h = (_Float16)f; return __builtin_bit_cast(u16, h); }
__device__ __forceinline__ float h2f(u16 b) { return (float)__builtin_bit_cast(_Float16, b); }
__device__ __forceinline__ float siluf(float v) { return v / (1.f + __expf(-v)); }
__device__ __forceinline__ float sigmf(float v) { return 1.f / (1.f + __expf(-v)); }
__device__ __forceinline__ float wave_sum(float v) {
#pragma unroll
  for (int o = 32; o >= 1; o >>= 1) v += __shfl_xor(v, o);
  return v;
}

struct Params {
  const float* x; const float* norm_w; const float* w_in; const float* lb_logits; const float* hg_nw;
  const float* conv_w; const float* conv_b; const float* dt_bias; const float* a_log; const float* d_skip;
  const float* m2_nw; const float* w_out; const float* fin_w;
  float* out;
  u16* h; u16* Wt1; u16* Wt2; u16* proj; float* dt; u16* mix; float* lb; float* xres;
};

__device__ void transpose_cvt(const float* src, int K, int N, u16* dst, float* tile  ) {
  const int tid = threadIdx.x;
  const int nk = K / 32, nn = (N + 31) / 32;
  for (int t = blockIdx.x; t < nk * nn; t += gridDim.x) {
    const int tk = t % nk, tn = t / nk;
    for (int i = tid; i < 1024; i += blockDim.x) { const int r = i >> 5, c = i & 31; const int n = tn * 32 + c;
      tile[r * 33 + c] = (n < N) ? src[(size_t)(tk * 32 + r) * N + n] : 0.f; }
    __syncthreads();
    for (int i = tid; i < 1024; i += blockDim.x) { const int r = i >> 5, c = i & 31; const int n = tn * 32 + r;
      if (n < N) dst[(size_t)n * K + tk * 32 + c] = f2bf(tile[c * 33 + r]); }
    __syncthreads();
  }
}

__device__ void phase_prep(const Params& p, char* smem) {
  const int tid = threadIdx.x, lane = tid & 63, wid = tid >> 6;
  const int gt = blockIdx.x * blockDim.x + tid;
  if (gt < 1024) { const float l0 = p.lb_logits[gt], l1 = p.lb_logits[1024 + gt]; p.lb[gt] = 1.f / (1.f + expf(l1 - l0)); }
  transpose_cvt(p.w_in, 1024, kNIN, p.Wt1, (float*)smem);
  transpose_cvt(p.w_out, 2048, 1024, p.Wt2, (float*)smem);
  const int gw = blockIdx.x * (blockDim.x >> 6) + wid, GW = gridDim.x * (blockDim.x >> 6);
  for (int row = gw; row < kT; row += GW) {
    const float4* xr = (const float4*)(p.x + (size_t)row * 1024);
    float4 v[4]; float ss = 0.f;
#pragma unroll
    for (int i = 0; i < 4; ++i) { v[i] = xr[i * 64 + lane]; ss += v[i].x * v[i].x + v[i].y * v[i].y + v[i].z * v[i].z + v[i].w * v[i].w; }
    ss = wave_sum(ss);
    const float rs = rsqrtf(ss * (1.f / 1024.f) + kEps);
#pragma unroll
    for (int i = 0; i < 4; ++i) { const float4 w = ((const float4*)p.norm_w)[i * 64 + lane];
      uint2 o; o.x = (unsigned)f2bf(v[i].x * rs * w.x) | ((unsigned)f2bf(v[i].y * rs * w.y) << 16);
      o.y = (unsigned)f2bf(v[i].z * rs * w.z) | ((unsigned)f2bf(v[i].w * rs * w.w) << 16);
      *(uint2*)(p.h + (size_t)row * 1024 + (i * 64 + lane) * 4) = o; }
  }
}

namespace pg8 {
#define PG8_LAS __attribute__((address_space(3)))
typedef unsigned short bf16_t;
typedef short bf16x8 __attribute__((ext_vector_type(8)));
typedef float f32x4 __attribute__((ext_vector_type(4)));
typedef unsigned u32x4 __attribute__((ext_vector_type(4)));
constexpr int BM = 256, BK = 64, HALF = 128, HTB = HALF * BK * 2  , STAGE_BYTES = 8 * HTB, NXCD = 8, WGM = 8;

__host__ __device__ __forceinline__ int lds_byte(int r, int c) { const int st = (r >> 4) * 2 + (c >> 5), rr = r & 15, cc = c & 31, ob = rr * 64 + cc * 2; return st * 1024 + (ob ^ (((ob >> 9) & 1) << 5)); }
__host__ __device__ __forceinline__ void stage_rc(int b, int& R, int& C) { const int st = b / 1024, sb = b % 1024, swz = sb ^ (((sb >> 9) & 1) << 5); R = (st >> 1) * 16 + swz / 64; C = (st & 1) * 32 + (swz % 64) / 2; }
__host__ __device__ __forceinline__ int perm32(int rho) { const int n = rho >> 4, i = rho & 15; return 8 * (i >> 2) + 4 * n + (i & 3); }

struct Unit { int pm, pn; };
struct Gemm { const bf16_t* A; const bf16_t* Bt; int M, N, K; };

struct StaticOrder {
    int nM, nN, nwg, G, c;
    __host__ __device__ void init(int M, int N, int G_, int c_) { nM = M / BM; nN = N / BM; nwg = nM * nN; G = G_; c = c_; }
    __host__ __device__ bool next(int i, Unit& u) const {
        const long L = (long)i * G + c; if (L >= nwg) return false;
        int wgid = (int)L; { const int q = nwg / NXCD, r = nwg % NXCD, xcd = wgid % NXCD, off = wgid / NXCD; wgid = (xcd < r ? xcd * (q + 1) : r * (q + 1) + (xcd - r) * q) + off; }
        const int nig = WGM * nN, gid = wgid / nig, fm = gid * WGM, gsz = (nM - fm) < WGM ? (nM - fm) : WGM;
        u.pm = fm + ((wgid % nig) % gsz); u.pn = (wgid % nig) / gsz; return true;
    }
    __device__ __forceinline__ void a_ready(const Unit&) const {}
    __device__ __forceinline__ void done(const Unit&) const {}
};
__device__ __forceinline__ unsigned cvt_pk_bf16(float lo, float hi) { unsigned r; asm volatile("v_cvt_pk_bf16_f32 %0, %1, %2" : "=v"(r) : "v"(lo), "v"(hi)); return r; }
template <class Epi, class Sched, bool STAMP = false>
__device__ __forceinline__ void gemm_phase(PG8_LAS unsigned char* lds, const Gemm g, const Sched& S, const Epi& E, unsigned long long* stamps) {
    const int tid = threadIdx.x, wid = __builtin_amdgcn_readfirstlane(tid >> 6), lane = tid & 63, wr = wid >> 2, wc = wid & 3, fr = lane & 15, fq = lane >> 4;
    const int K = g.K, nt = K / BK;
    int ts_lo = 0, ts_hi = 0, nts = 0; const unsigned long long rt_entry = STAMP ? (unsigned long long)wall_clock64() : 0ull;
#define PG8_STAMP() do { if (STAMP && wid == 0 && nts < 64) { const unsigned long long _c = (unsigned long long)clock64(); \
        ts_lo = (lane == nts) ? (int)(unsigned)_c : ts_lo; ts_hi = (lane == nts) ? (int)(unsigned)(_c >> 32) : ts_hi; ++nts; } } while (0)
    PG8_STAMP();
    unsigned voffA[2], voffB[2];
#pragma unroll
    for (int i = 0; i < 2; ++i) { int R, C; stage_rc(tid * 16 + i * 8192, R, C); const int Rb = Epi::PERM ? ((R & ~31) + perm32(R & 31)) : R;
        voffA[i] = (unsigned)(R * K + C) * 2u; voffB[i] = (unsigned)(Rb * K + C) * 2u; }
    const size_t kstep = (size_t)(BK * 2);
    const size_t hstep = (size_t)HALF * K * 2;
    const size_t tstep = 2 * hstep;
    const unsigned ldsw = (unsigned)wid * 1024u;
    const int aoff = lds_byte(wr * 64 + fr, fq * 8), boff = lds_byte(wc * 32 + fr, fq * 8);
#define PG8_SA(b, h) (((b) * 2 + (h)) * HTB)
#define PG8_SB(b, h) ((4 + (b) * 2 + (h)) * HTB)
#define PG8_STAGE(bufoff, gbase, voff) do { _Pragma("unroll") for (int _i = 0; _i < 2; ++_i) \
        __builtin_amdgcn_global_load_lds((const unsigned*)((const char*)(gbase) + (voff)[_i]), (PG8_LAS unsigned*)(lds + (bufoff) + ldsw + _i * 8192), 16, 0, 0); } while (0)
#define PG8_LDA(dst, b, h) do { _Pragma("unroll") for (int m = 0; m < 4; ++m) _Pragma("unroll") for (int k = 0; k < 2; ++k) dst[m][k] = *(const PG8_LAS bf16x8*)(lds + PG8_SA(b, h) + aoff + m * 2048 + k * 1024); } while (0)
#define PG8_LDB(dst, b, h) do { _Pragma("unroll") for (int n = 0; n < 2; ++n) _Pragma("unroll") for (int k = 0; k < 2; ++k) dst[n][k] = *(const PG8_LAS bf16x8*)(lds + PG8_SB(b, h) + boff + n * 2048 + k * 1024); } while (0)
#define PG8_MMA(ai, bj, At, Bt) do { __builtin_amdgcn_s_setprio(1); _Pragma("unroll") for (int m = 0; m < 4; ++m) _Pragma("unroll") for (int n = 0; n < 2; ++n) _Pragma("unroll") for (int k = 0; k < 2; ++k) \
        acc[ai][bj][m][n] = __builtin_amdgcn_mfma_f32_16x16x32_bf16(Bt[n][k], At[m][k], acc[ai][bj][m][n], 0, 0, 0); __builtin_amdgcn_s_setprio(0); } while (0)
#define PG8_WAIT_V(n) asm volatile("s_waitcnt vmcnt(" #n ")" ::: "memory")
#define PG8_WAIT_L(n) asm volatile("s_waitcnt lgkmcnt(" #n ")" ::: "memory")
#define PG8_BAR __builtin_amdgcn_s_barrier()
#define PG8_SCHED __builtin_amdgcn_sched_barrier(0)
    Unit cur, nxt; int ui = 0;
    if (!S.next(0, cur)) return;
    f32x4 acc[2][2][4][2];
#pragma unroll
    for (int a = 0; a < 2; ++a)
#pragma unroll
        for (int b = 0; b < 2; ++b)
#pragma unroll
            for (int m = 0; m < 4; ++m)
#pragma unroll
                for (int n = 0; n < 2; ++n) acc[a][b][m][n] = (f32x4){0.f, 0.f, 0.f, 0.f};
    bf16x8 At[4][2], B0[2][2], B1[2][2];
    const char* cA = (const char*)g.A + (size_t)cur.pm * tstep; const char* cB = (const char*)g.Bt + (size_t)cur.pn * tstep;
    S.a_ready(cur);
    PG8_STAGE(PG8_SB(0, 0), cB, voffB); PG8_STAGE(PG8_SA(0, 0), cA, voffA); PG8_STAGE(PG8_SB(0, 1), cB + hstep, voffB); PG8_STAGE(PG8_SA(0, 1), cA + hstep, voffA);
    if (wr == 1) PG8_BAR;
    PG8_WAIT_V(4); PG8_BAR;
    PG8_STAGE(PG8_SB(1, 0), cB + kstep, voffB); PG8_STAGE(PG8_SA(1, 0), cA + kstep, voffA); PG8_STAGE(PG8_SB(1, 1), cB + hstep + kstep, voffB);
    PG8_WAIT_V(6); PG8_BAR;
    PG8_STAMP();
    for (;;) {
        const bool has_next = S.next(ui + 1, nxt);
        const char* nA = has_next ? (const char*)g.A + (size_t)nxt.pm * tstep : cA; const char* nB = has_next ? (const char*)g.Bt + (size_t)nxt.pn * tstep : cB;
        for (int t = 0; t < nt; t += 2) {
            const bool last = (t == nt - 2);
            const char* a1 = cA + (size_t)(t + 1) * kstep;
            const char* a2 = last ? nA : cA + (size_t)(t + 2) * kstep; const char* b2 = last ? nB : cB + (size_t)(t + 2) * kstep;
            const char* a3 = a2 + kstep; const char* b3 = b2 + kstep;
            if (last && has_next) S.a_ready(nxt);
            PG8_LDB(B0, 0, 0); PG8_SCHED; PG8_LDA(At, 0, 0); PG8_STAGE(PG8_SA(1, 1), a1 + hstep, voffA);
            PG8_WAIT_L(8); PG8_BAR; PG8_WAIT_L(0); PG8_MMA(0, 0, At, B0); PG8_BAR; PG8_SCHED;
            PG8_LDB(B1, 0, 1); PG8_STAGE(PG8_SB(0, 0), b2, voffB);
            PG8_BAR; PG8_WAIT_L(0); PG8_MMA(0, 1, At, B1); PG8_BAR;
            PG8_LDA(At, 0, 1); PG8_STAGE(PG8_SA(0, 0), a2, voffA);
            PG8_BAR; PG8_WAIT_L(0); PG8_MMA(1, 0, At, B0); PG8_BAR; PG8_SCHED;
            PG8_STAGE(PG8_SB(0, 1), b2 + hstep, voffB);
            PG8_WAIT_V(6); PG8_BAR; PG8_MMA(1, 1, At, B1); PG8_BAR;
            PG8_LDB(B0, 1, 0); PG8_SCHED; PG8_LDA(At, 1, 0); PG8_STAGE(PG8_SA(0, 1), a2 + hstep, voffA);
            PG8_WAIT_L(8); PG8_BAR; PG8_WAIT_L(0); PG8_MMA(0, 0, At, B0); PG8_BAR; PG8_SCHED;
            PG8_LDB(B1, 1, 1); PG8_STAGE(PG8_SB(1, 0), b3, voffB);
            PG8_BAR; PG8_WAIT_L(0); PG8_MMA(0, 1, At, B1); PG8_BAR;
            PG8_LDA(At, 1, 1); PG8_STAGE(PG8_SA(1, 0), a3, voffA);
            PG8_BAR; PG8_WAIT_L(0); PG8_MMA(1, 0, At, B0); PG8_BAR; PG8_SCHED;
            PG8_STAGE(PG8_SB(1, 1), b3 + hstep, voffB);
            PG8_WAIT_V(6); PG8_BAR; PG8_MMA(1, 1, At, B1); PG8_BAR;
        }
        PG8_STAMP();
        if constexpr (!Epi::AFTER_DRAIN) { E(acc, cur, wr, wc, fr, fq); S.done(cur); }
        PG8_STAMP();
        if (!has_next) break;
#pragma unroll
        for (int a = 0; a < 2; ++a)
#pragma unroll
            for (int b = 0; b < 2; ++b)
#pragma unroll
                for (int m = 0; m < 4; ++m)
#pragma unroll
                    for (int n = 0; n < 2; ++n) acc[a][b][m][n] = (f32x4){0.f, 0.f, 0.f, 0.f};
        cur = nxt; cA = nA; cB = nB; ++ui;
    }
    PG8_WAIT_V(0);
    if (wr == 0) PG8_BAR;
    PG8_BAR;
    if constexpr (Epi::AFTER_DRAIN) { E.fused(acc, cur, wr, wc, fr, fq, lds, wid, lane); S.done(cur); }
    PG8_STAMP();
    if (STAMP && wid == 0) { stamps[lane] = lane < nts ? (((unsigned long long)(unsigned)ts_hi << 32) | (unsigned)ts_lo) : 0ull;
        if (lane == 62) stamps[62] = rt_entry; if (lane == 63) stamps[63] = (unsigned long long)wall_clock64(); }
#undef PG8_STAMP
#undef PG8_SA
#undef PG8_SB
#undef PG8_STAGE
#undef PG8_LDA
#undef PG8_LDB
#undef PG8_MMA
#undef PG8_WAIT_V
#undef PG8_WAIT_L
#undef PG8_BAR
#undef PG8_SCHED
}
}

struct Epi1F {
  static constexpr bool PERM = true, AFTER_DRAIN = false;
  u16* proj; const float* lb;
  __device__ __forceinline__ void operator()(const f32x4 (&acc)[2][2][4][2], const pg8::Unit& u, int wr, int wc, int fr, int fq) const {
    const int row0 = u.pm * 256 + wr * 64 + fr, col0 = u.pn * 256 + wc * 32 + 8 * fq;
    const int kind = (u.pn * 256) >> 10;
    f32x4 lbv[2][2];
#pragma unroll
    for (int bj = 0; bj < 2; ++bj)
#pragma unroll
      for (int n = 0; n < 2; ++n) lbv[bj][n] = (kind == 1) ? *(const f32x4*)(lb + (col0 - 1024) + bj * 128 + 4 * n) : (f32x4){0.f, 0.f, 0.f, 0.f};
#pragma unroll
    for (int ai = 0; ai < 2; ++ai)
#pragma unroll
      for (int m = 0; m < 4; ++m) { u16* rowp = proj + (size_t)(row0 + ai * 128 + m * 16) * kNP + col0;
#pragma unroll
        for (int bj = 0; bj < 2; ++bj) { f32x4 v0 = acc[ai][bj][m][0], v1 = acc[ai][bj][m][1];
          pg8::u32x4 w;
          if (kind == 1) {
            unsigned hw[8];
#pragma unroll
            for (int j = 0; j < 4; ++j) { const float l0 = lbv[bj][0][j], l1 = lbv[bj][1][j];
              hw[j] = f2h(__logf(l0 + (1.f - l0) * sigmf(v0[j]))); hw[4 + j] = f2h(__logf(l1 + (1.f - l1) * sigmf(v1[j]))); }
            w.x = hw[0] | (hw[1] << 16); w.y = hw[2] | (hw[3] << 16); w.z = hw[4] | (hw[5] << 16); w.w = hw[6] | (hw[7] << 16);
          } else {
            if (kind == 0 || kind == 3 || kind == 4) {
#pragma unroll
              for (int j = 0; j < 4; ++j) { v0[j] = siluf(v0[j]); v1[j] = siluf(v1[j]); } }
            w.x = pg8::cvt_pk_bf16(v0[0], v0[1]); w.y = pg8::cvt_pk_bf16(v0[2], v0[3]); w.z = pg8::cvt_pk_bf16(v1[0], v1[1]); w.w = pg8::cvt_pk_bf16(v1[2], v1[3]);
          }
          *(pg8::u32x4*)(rowp + bj * 128) = w; } }
  }
};
struct Epi2F {
  static constexpr bool PERM = false, AFTER_DRAIN = false;
  float* xres; const float* x;
  __device__ __forceinline__ void operator()(const f32x4 (&acc)[2][2][4][2], const pg8::Unit& u, int wr, int wc, int fr, int fq) const {
    const int row0 = u.pm * 256 + wr * 64 + fr, col0 = u.pn * 256 + wc * 32 + 4 * fq;
#pragma unroll
    for (int ai = 0; ai < 2; ++ai)
#pragma unroll
      for (int m = 0; m < 4; ++m) { const size_t ro = (size_t)(row0 + ai * 128 + m * 16) * 1024 + col0;
#pragma unroll
        for (int bj = 0; bj < 2; ++bj)
#pragma unroll
          for (int n = 0; n < 2; ++n) { const size_t o = ro + bj * 128 + n * 16; const f32x4 xv = *(const f32x4*)(x + o); *(f32x4*)(xres + o) = acc[ai][bj][m][n] + xv; } }
  }
};

__device__ __forceinline__ u16 xform1(int c, float v, const float* lb) {
  if (c < 1024) return f2bf(siluf(v));
  if (c < 2048) { const float l = lb[c - 1024]; const float f = l + (1.f - l) * sigmf(v); return f2h(logf(f)); }
  if (c < 3072) return f2bf(v);
  if (c < 5120) return f2bf(siluf(v));
  return f2bf(v);
}
struct Epi1 { u16* proj; const float* lb;
  __device__ __forceinline__ void operator()(int r, int c, float v) const { proj[(size_t)r * kNP + c] = xform1(c, v, lb); } };
struct Epi2 { float* xres; const float* x;
  __device__ __forceinline__ void operator()(int r, int c, float v) const { xres[(size_t)r * 1024 + c] = x[(size_t)r * 1024 + c] + v; } };

template <class Epi>
__device__ void gemm_naive(const u16* A, const u16* Bt, int M, int N, int K, const Epi& epi) {
  const int tid = threadIdx.x, lane = tid & 63, wid = tid >> 6, fr = lane & 15, fq = lane >> 4;
  const int gw = blockIdx.x * (blockDim.x >> 6) + wid, GW = gridDim.x * (blockDim.x >> 6);
  const int nN = N / 32, ntile = (M / 32) * nN;
  for (int t = gw; t < ntile; t += GW) {
    const int m0 = (t / nN) * 32, n0 = (t % nN) * 32;
    f32x4 acc[2][2];
#pragma unroll
    for (int i = 0; i < 2; ++i)
#pragma unroll
      for (int j = 0; j < 2; ++j) acc[i][j] = (f32x4){0.f, 0.f, 0.f, 0.f};
    for (int k0 = 0; k0 < K; k0 += 32) {
      bf16x8 a[2], b[2];
#pragma unroll
      for (int i = 0; i < 2; ++i) a[i] = *(const bf16x8*)(A + (size_t)(m0 + i * 16 + fr) * K + k0 + fq * 8);
#pragma unroll
      for (int j = 0; j < 2; ++j) b[j] = *(const bf16x8*)(Bt + (size_t)(n0 + j * 16 + fr) * K + k0 + fq * 8);
#pragma unroll
      for (int i = 0; i < 2; ++i)
#pragma unroll
        for (int j = 0; j < 2; ++j) acc[i][j] = __builtin_amdgcn_mfma_f32_16x16x32_bf16(a[i], b[j], acc[i][j], 0, 0, 0);
    }
#pragma unroll
    for (int i = 0; i < 2; ++i)
#pragma unroll
      for (int j = 0; j < 2; ++j)
#pragma unroll
        for (int r = 0; r < 4; ++r) epi(m0 + i * 16 + fq * 4 + r, n0 + j * 16 + fr, acc[i][j][r]);
  }
}

__device__ void phase_dt(const Params& p) {
  const int tid = threadIdx.x, lane = tid & 63, wid = tid >> 6, fr = lane & 15, fq = lane >> 4;
  const int gw = blockIdx.x * (blockDim.x >> 6) + wid, GW = gridDim.x * (blockDim.x >> 6);
  for (int t = gw; t < kT / 16; t += GW) {
    const int m0 = t * 16;
    f32x4 acc = (f32x4){0.f, 0.f, 0.f, 0.f};
    for (int k0 = 0; k0 < 1024; k0 += 32) {
      const bf16x8 a = *(const bf16x8*)(p.h + (size_t)(m0 + fr) * 1024 + k0 + fq * 8);
      const bf16x8 b = *(const bf16x8*)(p.Wt1 + (size_t)(kNP + fr) * 1024 + k0 + fq * 8);
      acc = __builtin_amdgcn_mfma_f32_16x16x32_bf16(a, b, acc, 0, 0, 0);
    }
    const float bias = p.dt_bias[fr];
#pragma unroll
    for (int r = 0; r < 4; ++r) { const float v = acc[r] + bias; const float sp = v > 20.f ? v : log1pf(expf(v));
      p.dt[(size_t)(m0 + fq * 4 + r) * 16 + fr] = sp; }
  }
}

__device__ void hgrn2_naive(const Params& p, int unit, char* smem) {
  const int b = unit >> 3, hh = unit & 7;
  const int tid = threadIdx.x, v = tid & 127, kq = tid >> 7;
  float S[32];
#pragma unroll
  for (int i = 0; i < 32; ++i) S[i] = 0.f;
  float* sq = (float*)smem; float* sf = sq + 2048; float* sk = sf + 2048; float* sv = sk + 2048; float* sp = sv + 2048;
  for (int t0 = 0; t0 < kL; t0 += 16) {
    for (int i = tid; i < 2048; i += 512) { const int tt = i >> 7, c = i & 127; const size_t row = (size_t)(b * kL + t0 + tt) * kNP;
      sq[i] = bf2f(p.proj[row + hh * 128 + c]);
      const float f = __expf(h2f(p.proj[row + 1024 + hh * 128 + c])); sf[i] = f; sk[i] = 1.f - f;
      sv[i] = bf2f(p.proj[row + 2048 + hh * 128 + c]); }
    __syncthreads();
    for (int tt = 0; tt < 16; ++tt) { const float vv = sv[tt * 128 + v]; float acc = 0.f;
#pragma unroll
      for (int i = 0; i < 32; ++i) { const int k = kq * 32 + i; S[i] = sf[tt * 128 + k] * S[i] + sk[tt * 128 + k] * vv; acc += S[i] * sq[tt * 128 + k]; }
      sp[(kq * 16 + tt) * 128 + v] = acc; }
    __syncthreads();
    { const int tt = tid >> 5, l32 = tid & 31; float o[4]; float ss = 0.f;
#pragma unroll
      for (int j = 0; j < 4; ++j) { const int vv = l32 + 32 * j; o[j] = sp[(0 * 16 + tt) * 128 + vv] + sp[(1 * 16 + tt) * 128 + vv] + sp[(2 * 16 + tt) * 128 + vv] + sp[(3 * 16 + tt) * 128 + vv]; ss += o[j] * o[j]; }
#pragma unroll
      for (int off = 16; off >= 1; off >>= 1) ss += __shfl_xor(ss, off);
      const float rs = rsqrtf(ss * (1.f / 128.f) + kEps);
      const size_t row = (size_t)(b * kL + t0 + tt);
#pragma unroll
      for (int j = 0; j < 4; ++j) { const int vv = l32 + 32 * j; const float g = bf2f(p.proj[row * kNP + 3072 + hh * 128 + vv]);
        p.mix[row * 2048 + hh * 128 + vv] = f2bf(o[j] * rs * p.hg_nw[hh * 128 + vv] * g); } }
  }
}

__device__ void mamba2_naive(const Params& p, int unit, char* smem) {
  const int b = unit >> 4, hd = unit & 15, g = hd >> 3;
  const int tid = threadIdx.x, pp = tid & 63, nq = tid >> 6;
  float st[16];
#pragma unroll
  for (int i = 0; i < 16; ++i) st[i] = 0.f;
  const float A = -__expf(p.a_log[hd]), Dk = p.d_skip[hd];
  float* sx = (float*)smem; float* sB = sx + 16 * 64; float* sC = sB + 16 * 128; float* sdt = sC + 16 * 128; float* sp = sdt + 16;
  for (int t0 = 0; t0 < kL; t0 += 16) {
    for (int i = tid; i < 5120; i += 512) { const int tt = i / 320, c = i % 320;
      const int ch = c < 64 ? hd * 64 + c : (c < 192 ? 1024 + g * 128 + (c - 64) : 1280 + g * 128 + (c - 192));
      float acc = p.conv_b[ch];
#pragma unroll
      for (int j = 0; j < 4; ++j) { const int ts = t0 + tt - 3 + j; if (ts >= 0) acc += p.conv_w[j * 1536 + ch] * bf2f(p.proj[(size_t)(b * kL + ts) * kNP + 5120 + ch]); }
      acc = siluf(acc);
      if (c < 64) sx[tt * 64 + c] = acc; else if (c < 192) sB[tt * 128 + c - 64] = acc; else sC[tt * 128 + c - 192] = acc; }
    if (tid < 16) sdt[tid] = p.dt[(size_t)(b * kL + t0 + tid) * 16 + hd];
    __syncthreads();
    for (int tt = 0; tt < 16; ++tt) { const float dt = sdt[tt], dA = __expf(dt * A), dx = dt * sx[tt * 64 + pp]; float acc = 0.f;
#pragma unroll
      for (int i = 0; i < 16; ++i) { const int n = nq * 16 + i; st[i] = dA * st[i] + dx * sB[tt * 128 + n]; acc += st[i] * sC[tt * 128 + n]; }
      sp[(nq * 16 + tt) * 64 + pp] = acc; }
    __syncthreads();
    for (int i = tid; i < 1024; i += 512) { const int tt = i >> 6, q = i & 63; float y = Dk * sx[tt * 64 + q];
#pragma unroll
      for (int r = 0; r < 8; ++r) y += sp[(r * 16 + tt) * 64 + q];
      const size_t row = (size_t)(b * kL + t0 + tt); const float z = bf2f(p.proj[row * kNP + 4096 + hd * 64 + q]);
      p.mix[row * 2048 + 1024 + hd * 64 + q] = f2bf(y * z); }
    __syncthreads();
  }
}

__device__ void phase_m2norm(const Params& p) {
  const int tid = threadIdx.x, lane = tid & 63, wid = tid >> 6;
  const int gw = blockIdx.x * (blockDim.x >> 6) + wid, GW = gridDim.x * (blockDim.x >> 6);
  for (int it = gw; it < kT * 2; it += GW) {
    const int row = it >> 1, g = it & 1;
    u16* ptr = p.mix + (size_t)row * 2048 + 1024 + g * 512 + lane * 8;
    const uint4 raw = *(const uint4*)ptr; const unsigned rw[4] = {raw.x, raw.y, raw.z, raw.w};
    float v[8]; float ss = 0.f;
#pragma unroll
    for (int i = 0; i < 4; ++i) { v[2 * i] = __uint_as_float(rw[i] << 16); v[2 * i + 1] = __uint_as_float(rw[i] & 0xffff0000u); ss += v[2 * i] * v[2 * i] + v[2 * i + 1] * v[2 * i + 1]; }
    ss = wave_sum(ss);
    const float rs = rsqrtf(ss * (1.f / 512.f) + kEps);
    const float* nw = p.m2_nw + g * 512 + lane * 8;
    unsigned ow[4];
#pragma unroll
    for (int i = 0; i < 4; ++i) ow[i] = (unsigned)f2bf(v[2 * i] * rs * nw[2 * i]) | ((unsigned)f2bf(v[2 * i + 1] * rs * nw[2 * i + 1]) << 16);
    *(uint4*)ptr = make_uint4(ow[0], ow[1], ow[2], ow[3]);
  }
}

__device__ void phase_final(const Params& p) {
  const int tid = threadIdx.x, lane = tid & 63, wid = tid >> 6;
  const int gw = blockIdx.x * (blockDim.x >> 6) + wid, GW = gridDim.x * (blockDim.x >> 6);
  for (int row = gw; row < kT; row += GW) {
    const float4* xr = (const float4*)(p.xres + (size_t)row * 1024);
    float4 v[4]; float ss = 0.f;
#pragma unroll
    for (int i = 0; i < 4; ++i) { v[i] = xr[i * 64 + lane]; ss += v[i].x * v[i].x + v[i].y * v[i].y + v[i].z * v[i].z + v[i].w * v[i].w; }
    ss = wave_sum(ss);
    const float rs = rsqrtf(ss * (1.f / 1024.f) + kEps);
#pragma unroll
    for (int i = 0; i < 4; ++i) { const float4 w = ((const float4*)p.fin_w)[i * 64 + lane];
      float4 o; o.x = v[i].x * rs * w.x; o.y = v[i].y * rs * w.y; o.z = v[i].z * rs * w.z; o.w = v[i].w * rs * w.w;
      ((float4*)(p.out + (size_t)row * 1024))[i * 64 + lane] = o; }
  }
}

extern __shared__ __attribute__((aligned(16))) char g_smem[];
constexpr int kThreads = 512;
constexpr size_t kDynLds = 131072;
__global__ void __launch_bounds__(kThreads, 2) k_mega(Params p) {
  cg::grid_group grid = cg::this_grid();
  phase_prep(p, g_smem);
  grid.sync();
  { Epi1F e{p.proj, p.lb}; pg8::StaticOrder S; S.init(kT, kNP, (int)gridDim.x, (int)blockIdx.x);
    pg8::gemm_phase<Epi1F, pg8::StaticOrder, false>((PG8_LAS unsigned char*)g_smem, pg8::Gemm{p.h, p.Wt1, kT, kNP, 1024}, S, e, nullptr);
    phase_dt(p); }
  grid.sync();
  for (int u = blockIdx.x; u < 192; u += gridDim.x) { if (u < 64) hgrn2_naive(p, u, g_smem); else mamba2_naive(p, u - 64, g_smem); __syncthreads(); }
  grid.sync();
  phase_m2norm(p);
  grid.sync();
  { Epi2F e{p.xres, p.x}; pg8::StaticOrder S; S.init(kT, 1024, (int)gridDim.x, (int)blockIdx.x);
    pg8::gemm_phase<Epi2F, pg8::StaticOrder, false>((PG8_LAS unsigned char*)g_smem, pg8::Gemm{p.mix, p.Wt2, kT, 1024, 2048}, S, e, nullptr); }
  grid.sync();
  phase_final(p);
}

extern "C" void kernel_launch(void* const* d_in, const int* in_sizes, int n_in, void* d_out, int out_size, void* d_ws, size_t ws_size, hipStream_t stream) {
  Params p{};
  p.x = (const float*)d_in[0]; p.norm_w = (const float*)d_in[1]; p.w_in = (const float*)d_in[2]; p.lb_logits = (const float*)d_in[3];
  p.hg_nw = (const float*)d_in[4]; p.conv_w = (const float*)d_in[5]; p.conv_b = (const float*)d_in[6]; p.dt_bias = (const float*)d_in[7];
  p.a_log = (const float*)d_in[8]; p.d_skip = (const float*)d_in[9]; p.m2_nw = (const float*)d_in[10]; p.w_out = (const float*)d_in[11];
  p.fin_w = (const float*)d_in[12];
  p.out = (float*)d_out;
  char* ws = (char*)d_ws; size_t off = 0;
  auto take = [&](size_t bytes) { char* r = ws + off; off += (bytes + 255) & ~(size_t)255; return r; };
  p.proj = (u16*)take((size_t)kT * kNP * 2);
  p.xres = (float*)p.proj;
  p.Wt1 = (u16*)take((size_t)kNIN * 1024 * 2);
  p.Wt2 = (u16*)take((size_t)1024 * 2048 * 2);
  p.dt = (float*)take((size_t)kT * 16 * 4);
  p.lb = (float*)take(1024 * 4);
  p.h = (u16*)d_out;
  p.mix = (u16*)d_out;
  if (off > ws_size) { fprintf(stderr, "workspace too small: need %zu have %zu\n", off, ws_size); return; }
  static int grid_blocks = 0;
  if (!grid_blocks) {
    int dev = 0, cus = 0, per_cu = 0;
    hipGetDevice(&dev);
    hipFuncSetAttribute((const void*)k_mega, hipFuncAttributeMaxDynamicSharedMemorySize, (int)kDynLds);
    hipDeviceGetAttribute(&cus, hipDeviceAttributeMultiprocessorCount, dev);
    hipOccupancyMaxActiveBlocksPerMultiprocessor(&per_cu, k_mega, kThreads, kDynLds);
    if (per_cu > 2) per_cu = 2;
    grid_blocks = cus * per_cu;
  }
  void* args[] = {&p};
  hipError_t e = hipLaunchCooperativeKernel((void*)k_mega, dim3(grid_blocks), dim3(kThreads), args, kDynLds, stream);
  if (e != hipSuccess) fprintf(stderr, "cooperative launch failed: %s (grid %d)\n", hipGetErrorString(e), grid_blocks);
}
```

```cpp
#include <hip/hip_runtime.h>
#include <hip/hip_cooperative_groups.h>
#include <cstdio>
namespace cg = cooperative_groups;

typedef unsigned short u16;
typedef short bf16x8 __attribute__((ext_vector_type(8)));
typedef float f32x4 __attribute__((ext_vector_type(4)));

constexpr int kT = 32768, kL = 4096;
constexpr int kNP = 6656;
constexpr int kNIN = 6672;
constexpr float kEps = 1e-6f;

typedef __bf16 bf16x2_t __attribute__((ext_vector_type(2)));
typedef float f32x2_t __attribute__((ext_vector_type(2)));
__device__ __forceinline__ unsigned hw_pk_bf16(float lo, float hi) { const f32x2_t v = {lo, hi}; return __builtin_bit_cast(unsigned, __builtin_convertvector(v, bf16x2_t)); }
__device__ __forceinline__ u16 f2bf(float f) { return (u16)(hw_pk_bf16(f, 0.f) & 0xffffu); }
__device__ __forceinline__ float bf2f(u16 b) { return __uint_as_float(((unsigned)b) << 16); }
__device__ __forceinline__ u16 f2h(float f) { _Float16 h = (_Float16)f; return __builtin_bit_cast(u16, h); }
__device__ __forceinline__ float h2f(u16 b) { return (float)__builtin_bit_cast(_Float16, b); }
__device__ __forceinline__ float fast_exp(float x) { return __builtin_amdgcn_exp2f(x * 1.44269504088896f); }
__device__ __forceinline__ float fast_log(float x) { return __builtin_amdgcn_logf(x) * 0.693147180559945f; }
__device__ __forceinline__ float siluf(float v) { return v * __builtin_amdgcn_rcpf(1.f + fast_exp(-v)); }
__device__ __forceinline__ float sigmf(float v) { return __builtin_amdgcn_rcpf(1.f + fast_exp(-v)); }
__device__ __forceinline__ float wave_sum(float v) {
#pragma unroll
  for (int o = 32; o >= 1; o >>= 1) v += __shfl_xor(v, o);
  return v;
}

__device__ __forceinline__ int opaque_tid() { int t = threadIdx.x; asm volatile("" : "+v"(t)); return t; }

struct Params {
  const float* x; const float* norm_w; const float* w_in; const float* lb_logits; const float* hg_nw;
  const float* conv_w; const float* conv_b; const float* dt_bias; const float* a_log; const float* d_skip;
  const float* m2_nw; const float* w_out; const float* fin_w;
  float* out;
  u16* h; u16* Wt1; u16* Wt2; u16* proj; float* dt; u16* mix; float* lb; float* xres; float* dec; u16* halo; unsigned* bar; float* rowss; unsigned* pcnt; float* cbb; int use_cg_sync; int pad0;
};

__device__ void transpose_cvt(const float* src, int K, int N, u16* dst, float* tile  ) {
  const int tid = opaque_tid();
  const int nk = K / 128, nn = (N + 63) / 64;
  for (int t = blockIdx.x; t < nk * nn; t += gridDim.x) {
    const int tk = t % nk, tn = t / nk;
    float v[16];
#pragma unroll
    for (int e = 0; e < 16; ++e) { const int idx = e * 512 + tid, r = idx >> 6, c = idx & 63; const int n = tn * 64 + c;
      v[e] = (n < N) ? __builtin_nontemporal_load(src + (size_t)(tk * 128 + r) * N + n) : 0.f; }
#pragma unroll
    for (int e = 0; e < 16; ++e) { const int idx = e * 512 + tid, r = idx >> 6, c = idx & 63; tile[r * 65 + c] = v[e]; }
    __syncthreads();
#pragma unroll
    for (int e = 0; e < 8; ++e) { const int idx = e * 512 + tid, nr = idx >> 6, kp = idx & 63; const int n = tn * 64 + nr;
      if (n < N) *(unsigned*)(dst + (size_t)n * K + tk * 128 + 2 * kp) = hw_pk_bf16(tile[(2 * kp) * 65 + nr], tile[(2 * kp + 1) * 65 + nr]); }
    __syncthreads();
  }
}

__device__ void phase_prep(const Params& p, char* smem) {
  const int tid = opaque_tid(), lane = tid & 63, wid = tid >> 6;
  const int gt = blockIdx.x * blockDim.x + tid;
  if (gt < 1024) { const float l0 = p.lb_logits[gt], l1 = p.lb_logits[1024 + gt]; p.lb[gt] = 1.f / (1.f + expf(l1 - l0)); }
  transpose_cvt(p.w_in, 1024, kNIN, p.Wt1, (float*)smem);
  transpose_cvt(p.w_out, 2048, 1024, p.Wt2, (float*)smem);
  const int gw = blockIdx.x * (blockDim.x >> 6) + wid, GW = gridDim.x * (blockDim.x >> 6);
  for (int row0 = gw * 4; row0 < kT; row0 += GW * 4) {
    float4 v[4][4]; float ss[4];
#pragma unroll
    for (int r = 0; r < 4; ++r) { const f32x4* xr = (const f32x4*)(p.x + (size_t)(row0 + r) * 1024);
#pragma unroll
      for (int i = 0; i < 4; ++i) { const f32x4 t4 = __builtin_nontemporal_load(xr + i * 64 + lane); v[r][i] = make_float4(t4[0], t4[1], t4[2], t4[3]); } }
#pragma unroll
    for (int r = 0; r < 4; ++r) { float a = 0.f;
#pragma unroll
      for (int i = 0; i < 4; ++i) a += v[r][i].x * v[r][i].x + v[r][i].y * v[r][i].y + v[r][i].z * v[r][i].z + v[r][i].w * v[r][i].w;
      ss[r] = wave_sum(a); }
#pragma unroll
    for (int i = 0; i < 4; ++i) { const float4 w = ((const float4*)p.norm_w)[i * 64 + lane];
#pragma unroll
      for (int r = 0; r < 4; ++r) { const float rs = rsqrtf(ss[r] * (1.f / 1024.f) + kEps);
        uint2 o; o.x = hw_pk_bf16(v[r][i].x * rs * w.x, v[r][i].y * rs * w.y); o.y = hw_pk_bf16(v[r][i].z * rs * w.z, v[r][i].w * rs * w.w);
        *(uint2*)(p.h + (size_t)(row0 + r) * 1024 + (i * 64 + lane) * 4) = o; } }
  }
}

namespace pg8 {
#define PG8_LAS __attribute__((address_space(3)))
typedef unsigned short bf16_t;
typedef short bf16x8 __attribute__((ext_vector_type(8)));
typedef float f32x4 __attribute__((ext_vector_type(4)));
typedef unsigned u32x4 __attribute__((ext_vector_type(4)));
constexpr int BM = 256, BK = 64, HALF = 128, HTB = HALF * BK * 2  , STAGE_BYTES = 8 * HTB, NXCD = 8, WGM = 4;

__host__ __device__ __forceinline__ int lds_byte(int r, int c) { const int st = (r >> 4) * 2 + (c >> 5), rr = r & 15, cc = c & 31, ob = rr * 64 + cc * 2; return st * 1024 + (ob ^ (((ob >> 9) & 1) << 5)); }
__host__ __device__ __forceinline__ void stage_rc(int b, int& R, int& C) { const int st = b / 1024, sb = b % 1024, swz = sb ^ (((sb >> 9) & 1) << 5); R = (st >> 1) * 16 + swz / 64; C = (st & 1) * 32 + (swz % 64) / 2; }
__host__ __device__ __forceinline__ int perm32(int rho) { const int n = rho >> 4, i = rho & 15; return 8 * (i >> 2) + 4 * n + (i & 3); }

struct Unit { int pm, pn; };
struct Gemm { const bf16_t* A; const bf16_t* Bt; int M, N, K; };

struct StaticOrder {
    int nM, nN, nwg, G, c;
    __host__ __device__ void init(int M, int N, int G_, int c_) { nM = M / BM; nN = N / BM; nwg = nM * nN; G = G_; c = c_; }
    __host__ __device__ bool next(int i, Unit& u) const {
        const long L = (long)i * G + c; if (L >= nwg) return false;
        int wgid = (int)L; { const int q = nwg / NXCD, r = nwg % NXCD, xcd = wgid % NXCD, off = wgid / NXCD; wgid = (xcd < r ? xcd * (q + 1) : r * (q + 1) + (xcd - r) * q) + off; }
        const int nig = WGM * nN, gid = wgid / nig, fm = gid * WGM, gsz = (nM - fm) < WGM ? (nM - fm) : WGM;
        u.pm = fm + ((wgid % nig) % gsz); u.pn = (wgid % nig) / gsz; return true;
    }
    __device__ __forceinline__ void a_ready(const Unit&) const {}
    __device__ __forceinline__ void done(const Unit&) const {}
};
__device__ __forceinline__ unsigned cvt_pk_bf16(float lo, float hi) { return hw_pk_bf16(lo, hi); }
template <class Epi, class Sched, bool STAMP = false>
__device__ __forceinline__ void gemm_phase(PG8_LAS unsigned char* lds, const Gemm g, const Sched& S, const Epi& E, unsigned long long* stamps) {
    const int tid = opaque_tid(), wid = __builtin_amdgcn_readfirstlane(tid >> 6), lane = tid & 63, wr = wid >> 2, wc = wid & 3, fr = lane & 15, fq = lane >> 4;
    const int K = g.K, nt = K / BK;
    int ts_lo = 0, ts_hi = 0, nts = 0; const unsigned long long rt_entry = STAMP ? (unsigned long long)wall_clock64() : 0ull;
#define PG8_STAMP() do { if (STAMP && wid == 0 && nts < 64) { const unsigned long long _c = (unsigned long long)clock64(); \
        ts_lo = (lane == nts) ? (int)(unsigned)_c : ts_lo; ts_hi = (lane == nts) ? (int)(unsigned)(_c >> 32) : ts_hi; ++nts; } } while (0)
    PG8_STAMP();
    unsigned voffA[2], voffB[2];
#pragma unroll
    for (int i = 0; i < 2; ++i) { int R, C; stage_rc(tid * 16 + i * 8192, R, C); const int Rb = Epi::PERM ? ((R & ~31) + perm32(R & 31)) : R;
        voffA[i] = (unsigned)(R * K + C) * 2u; voffB[i] = (unsigned)(Rb * K + C) * 2u; }
    const size_t kstep = (size_t)(BK * 2);
    const size_t hstep = (size_t)HALF * K * 2;
    const size_t tstep = 2 * hstep;
    const unsigned ldsw = (unsigned)wid * 1024u;
    const int aoff = lds_byte(wr * 64 + fr, fq * 8), boff = lds_byte(wc * 32 + fr, fq * 8);
#define PG8_SA(b, h) (((b) * 2 + (h)) * HTB)
#define PG8_SB(b, h) ((4 + (b) * 2 + (h)) * HTB)
#define PG8_STAGE(bufoff, gbase, voff) do { _Pragma("unroll") for (int _i = 0; _i < 2; ++_i) \
        __builtin_amdgcn_global_load_lds((const unsigned*)((const char*)(gbase) + (voff)[_i]), (PG8_LAS unsigned*)(lds + (bufoff) + ldsw + _i * 8192), 16, 0, 0); } while (0)
#define PG8_LDA(dst, b, h) do { _Pragma("unroll") for (int m = 0; m < 4; ++m) _Pragma("unroll") for (int k = 0; k < 2; ++k) dst[m][k] = *(const PG8_LAS bf16x8*)(lds + PG8_SA(b, h) + aoff + m * 2048 + k * 1024); } while (0)
#define PG8_LDB(dst, b, h) do { _Pragma("unroll") for (int n = 0; n < 2; ++n) _Pragma("unroll") for (int k = 0; k < 2; ++k) dst[n][k] = *(const PG8_LAS bf16x8*)(lds + PG8_SB(b, h) + boff + n * 2048 + k * 1024); } while (0)
#define PG8_MMA(ai, bj, At, Bt) do { __builtin_amdgcn_s_setprio(1); _Pragma("unroll") for (int m = 0; m < 4; ++m) _Pragma("unroll") for (int n = 0; n < 2; ++n) _Pragma("unroll") for (int k = 0; k < 2; ++k) \
        acc[ai][bj][m][n] = __builtin_amdgcn_mfma_f32_16x16x32_bf16(Bt[n][k], At[m][k], acc[ai][bj][m][n], 0, 0, 0); __builtin_amdgcn_s_setprio(0); } while (0)
#define PG8_WAIT_V(n) asm volatile("s_waitcnt vmcnt(" #n ")" ::: "memory")
#define PG8_WAIT_L(n) asm volatile("s_waitcnt lgkmcnt(" #n ")" ::: "memory")
#define PG8_BAR __builtin_amdgcn_s_barrier()
#define PG8_SCHED __builtin_amdgcn_sched_barrier(0)
    Unit cur, nxt; int ui = 0;
    if (!S.next(0, cur)) return;
    f32x4 acc[2][2][4][2];
#pragma unroll
    for (int a = 0; a < 2; ++a)
#pragma unroll
        for (int b = 0; b < 2; ++b)
#pragma unroll
            for (int m = 0; m < 4; ++m)
#pragma unroll
                for (int n = 0; n < 2; ++n) acc[a][b][m][n] = (f32x4){0.f, 0.f, 0.f, 0.f};
    bf16x8 At[4][2], B0[2][2], B1[2][2];
    const char* cA = (const char*)g.A + (size_t)cur.pm * tstep; const char* cB = (const char*)g.Bt + (size_t)cur.pn * tstep;
    S.a_ready(cur);
    PG8_STAGE(PG8_SB(0, 0), cB, voffB); PG8_STAGE(PG8_SA(0, 0), cA, voffA); PG8_STAGE(PG8_SB(0, 1), cB + hstep, voffB); PG8_STAGE(PG8_SA(0, 1), cA + hstep, voffA);
    if (wr == 1) PG8_BAR;
    PG8_WAIT_V(4); PG8_BAR;
    PG8_STAGE(PG8_SB(1, 0), cB + kstep, voffB); PG8_STAGE(PG8_SA(1, 0), cA + kstep, voffA); PG8_STAGE(PG8_SB(1, 1), cB + hstep + kstep, voffB);
    PG8_WAIT_V(6); PG8_BAR;
    PG8_STAMP();
    for (;;) {
        const bool has_next = S.next(ui + 1, nxt);
        const char* nA = has_next ? (const char*)g.A + (size_t)nxt.pm * tstep : cA; const char* nB = has_next ? (const char*)g.Bt + (size_t)nxt.pn * tstep : cB;
        for (int t = 0; t < nt; t += 2) {
            const bool last = (t == nt - 2);
            const char* a1 = cA + (size_t)(t + 1) * kstep;
            const char* a2 = last ? nA : cA + (size_t)(t + 2) * kstep; const char* b2 = last ? nB : cB + (size_t)(t + 2) * kstep;
            const char* a3 = a2 + kstep; const char* b3 = b2 + kstep;
            if (last && has_next) S.a_ready(nxt);
            PG8_LDB(B0, 0, 0); PG8_SCHED; PG8_LDA(At, 0, 0); PG8_STAGE(PG8_SA(1, 1), a1 + hstep, voffA);
            PG8_WAIT_L(8); PG8_BAR; PG8_WAIT_L(0); PG8_MMA(0, 0, At, B0); PG8_BAR; PG8_SCHED;
            PG8_LDB(B1, 0, 1); PG8_STAGE(PG8_SB(0, 0), b2, voffB);
            PG8_BAR; PG8_WAIT_L(0); PG8_MMA(0, 1, At, B1); PG8_BAR;
            PG8_LDA(At, 0, 1); PG8_STAGE(PG8_SA(0, 0), a2, voffA);
            PG8_BAR; PG8_WAIT_L(0); PG8_MMA(1, 0, At, B0); PG8_BAR; PG8_SCHED;
            PG8_STAGE(PG8_SB(0, 1), b2 + hstep, voffB);
            PG8_WAIT_V(6); PG8_BAR; PG8_MMA(1, 1, At, B1); PG8_BAR;
            PG8_LDB(B0, 1, 0); PG8_SCHED; PG8_LDA(At, 1, 0); PG8_STAGE(PG8_SA(0, 1), a2 + hstep, voffA);
            PG8_WAIT_L(8); PG8_BAR; PG8_WAIT_L(0); PG8_MMA(0, 0, At, B0); PG8_BAR; PG8_SCHED;
            PG8_LDB(B1, 1, 1); PG8_STAGE(PG8_SB(1, 0), b3, voffB);
            PG8_BAR; PG8_WAIT_L(0); PG8_MMA(0, 1, At, B1); PG8_BAR;
            PG8_LDA(At, 1, 1); PG8_STAGE(PG8_SA(1, 0), a3, voffA);
            PG8_BAR; PG8_WAIT_L(0); PG8_MMA(1, 0, At, B0); PG8_BAR; PG8_SCHED;
            PG8_STAGE(PG8_SB(1, 1), b3 + hstep, voffB);
            PG8_WAIT_V(6); PG8_BAR; PG8_MMA(1, 1, At, B1); PG8_BAR;
        }
        PG8_STAMP();
        if constexpr (!Epi::AFTER_DRAIN) { E(acc, cur, wr, wc, fr, fq); S.done(cur); }
        PG8_STAMP();
        if (!has_next) break;
#pragma unroll
        for (int a = 0; a < 2; ++a)
#pragma unroll
            for (int b = 0; b < 2; ++b)
#pragma unroll
                for (int m = 0; m < 4; ++m)
#pragma unroll
                    for (int n = 0; n < 2; ++n) acc[a][b][m][n] = (f32x4){0.f, 0.f, 0.f, 0.f};
        cur = nxt; cA = nA; cB = nB; ++ui;
    }
    PG8_WAIT_V(0);
    if (wr == 0) PG8_BAR;
    PG8_BAR;
    if constexpr (Epi::AFTER_DRAIN) { E.fused(acc, cur, wr, wc, fr, fq, lds, wid, lane); S.done(cur); }
    PG8_STAMP();
    if (STAMP && wid == 0) { stamps[lane] = lane < nts ? (((unsigned long long)(unsigned)ts_hi << 32) | (unsigned)ts_lo) : 0ull;
        if (lane == 62) stamps[62] = rt_entry; if (lane == 63) stamps[63] = (unsigned long long)wall_clock64(); }
#undef PG8_STAMP
#undef PG8_SA
#undef PG8_SB
#undef PG8_STAGE
#undef PG8_LDA
#undef PG8_LDB
#undef PG8_MMA
#undef PG8_WAIT_V
#undef PG8_WAIT_L
#undef PG8_BAR
#undef PG8_SCHED
}
}

struct Epi1F {
  static constexpr bool PERM = true, AFTER_DRAIN = false;
  u16* proj; const float* lb;
  __device__ __forceinline__ void operator()(const f32x4 (&acc)[2][2][4][2], const pg8::Unit& u, int wr, int wc, int fr, int fq) const {
    const int row0 = u.pm * 256 + wr * 64 + fr, col0 = u.pn * 256 + wc * 32 + 8 * fq;
    const int kind = (u.pn * 256) >> 10;
    f32x4 lbv[2][2];
#pragma unroll
    for (int bj = 0; bj < 2; ++bj)
#pragma unroll
      for (int n = 0; n < 2; ++n) lbv[bj][n] = (kind == 1) ? *(const f32x4*)(lb + (col0 - 1024) + bj * 128 + 4 * n) : (f32x4){0.f, 0.f, 0.f, 0.f};
#pragma unroll
    for (int ai = 0; ai < 2; ++ai)
#pragma unroll
      for (int m = 0; m < 4; ++m) { u16* rowp = proj + (size_t)(row0 + ai * 128 + m * 16) * kNP + col0;
#pragma unroll
        for (int bj = 0; bj < 2; ++bj) { f32x4 v0 = acc[ai][bj][m][0], v1 = acc[ai][bj][m][1];
          pg8::u32x4 w;
          if (kind == 1) {
            unsigned hw[8];
#pragma unroll
            for (int j = 0; j < 4; ++j) { const float l0 = lbv[bj][0][j], l1 = lbv[bj][1][j];
              hw[j] = f2h(fast_log(l0 + (1.f - l0) * sigmf(v0[j]))); hw[4 + j] = f2h(fast_log(l1 + (1.f - l1) * sigmf(v1[j]))); }
            w.x = hw[0] | (hw[1] << 16); w.y = hw[2] | (hw[3] << 16); w.z = hw[4] | (hw[5] << 16); w.w = hw[6] | (hw[7] << 16);
          } else {
            if (kind == 0 || kind == 3 || kind == 4) {
#pragma unroll
              for (int j = 0; j < 4; ++j) { v0[j] = siluf(v0[j]); v1[j] = siluf(v1[j]); } }
            w.x = pg8::cvt_pk_bf16(v0[0], v0[1]); w.y = pg8::cvt_pk_bf16(v0[2], v0[3]); w.z = pg8::cvt_pk_bf16(v1[0], v1[1]); w.w = pg8::cvt_pk_bf16(v1[2], v1[3]);
          }
          __builtin_nontemporal_store(w, (pg8::u32x4*)(rowp + bj * 128)); } }
  }
};
struct Epi2F {
  static constexpr bool PERM = false, AFTER_DRAIN = false;
  float* xres; const float* x;
  __device__ __forceinline__ void operator()(const f32x4 (&acc)[2][2][4][2], const pg8::Unit& u, int wr, int wc, int fr, int fq) const {
    const int row0 = u.pm * 256 + wr * 64 + fr, col0 = u.pn * 256 + wc * 32 + 4 * fq;
#pragma unroll
    for (int ai = 0; ai < 2; ++ai)
#pragma unroll
      for (int m = 0; m < 4; ++m) { const size_t ro = (size_t)(row0 + ai * 128 + m * 16) * 1024 + col0;
#pragma unroll
        for (int bj = 0; bj < 2; ++bj)
#pragma unroll
          for (int n = 0; n < 2; ++n) { const size_t o = ro + bj * 128 + n * 16; const f32x4 xv = *(const f32x4*)(x + o); *(f32x4*)(xres + o) = acc[ai][bj][m][n] + xv; } }
  }
};

struct Epi2N {
  static constexpr bool PERM = false, AFTER_DRAIN = false;
  float* out; const float* x; const float* fw; float* rowss; unsigned* pcnt;
  __device__ __forceinline__ void operator()(const f32x4 (&acc_c)[2][2][4][2], const pg8::Unit& u, int wr, int wc, int fr, int fq) const {
    f32x4 (&acc)[2][2][4][2] = const_cast<f32x4 (&)[2][2][4][2]>(acc_c);
    const int row0 = u.pm * 256 + wr * 64 + fr, col0 = u.pn * 256 + wc * 32 + 4 * fq;
    float ps[8];
#pragma unroll
    for (int ai = 0; ai < 2; ++ai)
#pragma unroll
      for (int m = 0; m < 4; ++m) { const size_t ro = (size_t)(row0 + ai * 128 + m * 16) * 1024 + col0; float sq = 0.f;
#pragma unroll
        for (int bj = 0; bj < 2; ++bj)
#pragma unroll
          for (int n = 0; n < 2; ++n) { const f32x4 xv = __builtin_nontemporal_load((const f32x4*)(x + ro + bj * 128 + n * 16)); const f32x4 v = acc[ai][bj][m][n] + xv; acc[ai][bj][m][n] = v;
            sq += v[0] * v[0] + v[1] * v[1] + v[2] * v[2] + v[3] * v[3]; }
        sq += __shfl_xor(sq, 16); sq += __shfl_xor(sq, 32); ps[ai * 4 + m] = sq; }
#pragma unroll
    for (int k = 0; k < 8; ++k)
      if ((k >> 1) == fq) (void)__hip_atomic_fetch_add(rowss + row0 + (k >> 2) * 128 + (k & 3) * 16, ps[k], __ATOMIC_RELAXED, __HIP_MEMORY_SCOPE_AGENT);
    asm volatile("s_waitcnt vmcnt(0)" ::: "memory");
    unsigned* cnt = pcnt + u.pm * 2 + wr;
    if (fr == 0 && fq == 0) (void)__hip_atomic_fetch_add(cnt, 1u, __ATOMIC_RELAXED, __HIP_MEMORY_SCOPE_AGENT);
    { unsigned spins = 0;
      while (__hip_atomic_load(cnt, __ATOMIC_RELAXED, __HIP_MEMORY_SCOPE_AGENT) < 16u && ++spins < (1u << 22)) __builtin_amdgcn_s_sleep(1); }
    float rs[8];
#pragma unroll
    for (int k = 0; k < 8; ++k) rs[k] = rsqrtf(__hip_atomic_load(rowss + row0 + (k >> 2) * 128 + (k & 3) * 16, __ATOMIC_RELAXED, __HIP_MEMORY_SCOPE_AGENT) * (1.f / 1024.f) + kEps);
    f32x4 wv[2][2];
#pragma unroll
    for (int bj = 0; bj < 2; ++bj)
#pragma unroll
      for (int n = 0; n < 2; ++n) wv[bj][n] = *(const f32x4*)(fw + col0 + bj * 128 + n * 16);
#pragma unroll
    for (int ai = 0; ai < 2; ++ai)
#pragma unroll
      for (int m = 0; m < 4; ++m) { const size_t ro = (size_t)(row0 + ai * 128 + m * 16) * 1024 + col0; const float r = rs[ai * 4 + m];
#pragma unroll
        for (int bj = 0; bj < 2; ++bj)
#pragma unroll
          for (int n = 0; n < 2; ++n) __builtin_nontemporal_store(acc[ai][bj][m][n] * r * wv[bj][n], (f32x4*)(out + ro + bj * 128 + n * 16)); }
  }
};

__device__ __forceinline__ u16 xform1(int c, float v, const float* lb) {
  if (c < 1024) return f2bf(siluf(v));
  if (c < 2048) { const float l = lb[c - 1024]; const float f = l + (1.f - l) * sigmf(v); return f2h(logf(f)); }
  if (c < 3072) return f2bf(v);
  if (c < 5120) return f2bf(siluf(v));
  return f2bf(v);
}
struct Epi1 { u16* proj; const float* lb;
  __device__ __forceinline__ void operator()(int r, int c, float v) const { proj[(size_t)r * kNP + c] = xform1(c, v, lb); } };
struct Epi2 { float* xres; const float* x;
  __device__ __forceinline__ void operator()(int r, int c, float v) const { xres[(size_t)r * 1024 + c] = x[(size_t)r * 1024 + c] + v; } };

template <class Epi>
__device__ void gemm_naive(const u16* A, const u16* Bt, int M, int N, int K, const Epi& epi) {
  const int tid = opaque_tid(), lane = tid & 63, wid = tid >> 6, fr = lane & 15, fq = lane >> 4;
  const int gw = blockIdx.x * (blockDim.x >> 6) + wid, GW = gridDim.x * (blockDim.x >> 6);
  const int nN = N / 32, ntile = (M / 32) * nN;
  for (int t = gw; t < ntile; t += GW) {
    const int m0 = (t / nN) * 32, n0 = (t % nN) * 32;
    f32x4 acc[2][2];
#pragma unroll
    for (int i = 0; i < 2; ++i)
#pragma unroll
      for (int j = 0; j < 2; ++j) acc[i][j] = (f32x4){0.f, 0.f, 0.f, 0.f};
    for (int k0 = 0; k0 < K; k0 += 32) {
      bf16x8 a[2], b[2];
#pragma unroll
      for (int i = 0; i < 2; ++i) a[i] = *(const bf16x8*)(A + (size_t)(m0 + i * 16 + fr) * K + k0 + fq * 8);
#pragma unroll
      for (int j = 0; j < 2; ++j) b[j] = *(const bf16x8*)(Bt + (size_t)(n0 + j * 16 + fr) * K + k0 + fq * 8);
#pragma unroll
      for (int i = 0; i < 2; ++i)
#pragma unroll
        for (int j = 0; j < 2; ++j) acc[i][j] = __builtin_amdgcn_mfma_f32_16x16x32_bf16(a[i], b[j], acc[i][j], 0, 0, 0);
    }
#pragma unroll
    for (int i = 0; i < 2; ++i)
#pragma unroll
      for (int j = 0; j < 2; ++j)
#pragma unroll
        for (int r = 0; r < 4; ++r) epi(m0 + i * 16 + fq * 4 + r, n0 + j * 16 + fr, acc[i][j][r]);
  }
}

__device__ void phase_dt(const Params& p) {
  const int tid = opaque_tid(), lane = tid & 63, wid = tid >> 6, fr = lane & 15, fq = lane >> 4;
  const int gw = blockIdx.x * (blockDim.x >> 6) + wid, GW = gridDim.x * (blockDim.x >> 6);
  for (int t = gw; t < kT / 16; t += GW) {
    const int m0 = t * 16;
    f32x4 acc = (f32x4){0.f, 0.f, 0.f, 0.f};
    for (int k0 = 0; k0 < 1024; k0 += 32) {
      const bf16x8 a = *(const bf16x8*)(p.h + (size_t)(m0 + fr) * 1024 + k0 + fq * 8);
      const bf16x8 b = *(const bf16x8*)(p.Wt1 + (size_t)(kNP + fr) * 1024 + k0 + fq * 8);
      acc = __builtin_amdgcn_mfma_f32_16x16x32_bf16(a, b, acc, 0, 0, 0);
    }
    const float bias = p.dt_bias[fr];
#pragma unroll
    for (int r = 0; r < 4; ++r) { const float v = acc[r] + bias; const float sp = v > 20.f ? v : log1pf(expf(v));
      p.dt[(size_t)(m0 + fq * 4 + r) * 16 + fr] = sp; }
  }
}

__device__ void hgrn2_naive(const Params& p, int unit, char* smem) {
  const int b = unit >> 3, hh = unit & 7;
  const int tid = opaque_tid(), v = tid & 127, kq = tid >> 7;
  float S[32];
#pragma unroll
  for (int i = 0; i < 32; ++i) S[i] = 0.f;
  float* sq = (float*)smem; float* sf = sq + 2048; float* sk = sf + 2048; float* sv = sk + 2048; float* sp = sv + 2048;
  for (int t0 = 0; t0 < kL; t0 += 16) {
    for (int i = tid; i < 2048; i += 512) { const int tt = i >> 7, c = i & 127; const size_t row = (size_t)(b * kL + t0 + tt) * kNP;
      sq[i] = bf2f(p.proj[row + hh * 128 + c]);
      const float f = fast_exp(h2f(p.proj[row + 1024 + hh * 128 + c])); sf[i] = f; sk[i] = 1.f - f;
      sv[i] = bf2f(p.proj[row + 2048 + hh * 128 + c]); }
    __syncthreads();
    for (int tt = 0; tt < 16; ++tt) { const float vv = sv[tt * 128 + v]; float acc = 0.f;
#pragma unroll
      for (int i = 0; i < 32; ++i) { const int k = kq * 32 + i; S[i] = sf[tt * 128 + k] * S[i] + sk[tt * 128 + k] * vv; acc += S[i] * sq[tt * 128 + k]; }
      sp[(kq * 16 + tt) * 128 + v] = acc; }
    __syncthreads();
    { const int tt = tid >> 5, l32 = tid & 31; float o[4]; float ss = 0.f;
#pragma unroll
      for (int j = 0; j < 4; ++j) { const int vv = l32 + 32 * j; o[j] = sp[(0 * 16 + tt) * 128 + vv] + sp[(1 * 16 + tt) * 128 + vv] + sp[(2 * 16 + tt) * 128 + vv] + sp[(3 * 16 + tt) * 128 + vv]; ss += o[j] * o[j]; }
#pragma unroll
      for (int off = 16; off >= 1; off >>= 1) ss += __shfl_xor(ss, off);
      const float rs = rsqrtf(ss * (1.f / 128.f) + kEps);
      const size_t row = (size_t)(b * kL + t0 + tt);
#pragma unroll
      for (int j = 0; j < 4; ++j) { const int vv = l32 + 32 * j; const float g = bf2f(p.proj[row * kNP + 3072 + hh * 128 + vv]);
        p.mix[row * 2048 + hh * 128 + vv] = f2bf(o[j] * rs * p.hg_nw[hh * 128 + vv] * g); } }
  }
}

__device__ void mamba2_naive(const Params& p, int unit, char* smem) {
  const int b = unit >> 4, hd = unit & 15, g = hd >> 3;
  const int tid = opaque_tid(), pp = tid & 63, nq = tid >> 6;
  float st[16];
#pragma unroll
  for (int i = 0; i < 16; ++i) st[i] = 0.f;
  const float A = -fast_exp(p.a_log[hd]), Dk = p.d_skip[hd];
  float* sx = (float*)smem; float* sB = sx + 16 * 64; float* sC = sB + 16 * 128; float* sdt = sC + 16 * 128; float* sp = sdt + 16;
  for (int t0 = 0; t0 < kL; t0 += 16) {
    for (int i = tid; i < 5120; i += 512) { const int tt = i / 320, c = i % 320;
      const int ch = c < 64 ? hd * 64 + c : (c < 192 ? 1024 + g * 128 + (c - 64) : 1280 + g * 128 + (c - 192));
      float acc = p.conv_b[ch];
#pragma unroll
      for (int j = 0; j < 4; ++j) { const int ts = t0 + tt - 3 + j; if (ts >= 0) acc += p.conv_w[j * 1536 + ch] * bf2f(p.proj[(size_t)(b * kL + ts) * kNP + 5120 + ch]); }
      acc = siluf(acc);
      if (c < 64) sx[tt * 64 + c] = acc; else if (c < 192) sB[tt * 128 + c - 64] = acc; else sC[tt * 128 + c - 192] = acc; }
    if (tid < 16) sdt[tid] = p.dt[(size_t)(b * kL + t0 + tid) * 16 + hd];
    __syncthreads();
    for (int tt = 0; tt < 16; ++tt) { const float dt = sdt[tt], dA = fast_exp(dt * A), dx = dt * sx[tt * 64 + pp]; float acc = 0.f;
#pragma unroll
      for (int i = 0; i < 16; ++i) { const int n = nq * 16 + i; st[i] = dA * st[i] + dx * sB[tt * 128 + n]; acc += st[i] * sC[tt * 128 + n]; }
      sp[(nq * 16 + tt) * 64 + pp] = acc; }
    __syncthreads();
    for (int i = tid; i < 1024; i += 512) { const int tt = i >> 6, q = i & 63; float y = Dk * sx[tt * 64 + q];
#pragma unroll
      for (int r = 0; r < 8; ++r) y += sp[(r * 16 + tt) * 64 + q];
      const size_t row = (size_t)(b * kL + t0 + tt); const float z = bf2f(p.proj[row * kNP + 4096 + hd * 64 + q]);
      p.mix[row * 2048 + 1024 + hd * 64 + q] = f2bf(y * z); }
    __syncthreads();
  }
}

#define BUF_RSRC(ptr) __builtin_amdgcn_make_buffer_rsrc((void*)(ptr), 0, 0x7fffffff, 0x00020000)
#define BUF_LD(rs, voff, soff) ((unsigned)__builtin_amdgcn_raw_buffer_load_b32((rs), (int)(voff), (int)(soff), 0))
#define BUF_ST(val, rs, voff, soff) __builtin_amdgcn_raw_buffer_store_b32((unsigned)(val), (rs), (int)(voff), (int)(soff), 2)
__device__ void phase_premix(const Params& p) {
  const int tid = opaque_tid(), lane = tid & 63, wid = __builtin_amdgcn_readfirstlane(tid >> 6);
  const int gw = blockIdx.x * (blockDim.x >> 6) + wid, GW = gridDim.x * (blockDim.x >> 6);
  const int loff = lane * 4;
  constexpr int RB = kNP * 2;
  for (int it = gw; it < 4096 + 6144; it += GW) {
    if (it < 4096) {
      const int hh = it & 7, bc = it >> 3;
      const __amdgpu_buffer_rsrc_t rq = BUF_RSRC(p.proj + (size_t)(bc * 64) * kNP + hh * 128);
      unsigned lf[64];
#pragma unroll
      for (int t = 0; t < 64; ++t) lf[t] = BUF_LD(rq, loff, t * RB + 2048);
      float t0 = 0.f, t1 = 0.f;
#pragma unroll
      for (int t = 0; t < 64; ++t) { t0 += h2f((u16)(lf[t] & 0xffffu)); t1 += h2f((u16)(lf[t] >> 16)); }
      float2 dv; dv.x = fast_exp(t0); dv.y = fast_exp(t1);
      *(float2*)(p.dec + (size_t)bc * 1024 + hh * 128 + 2 * lane) = dv;
      float c0 = 0.f, c1 = 0.f;
#pragma unroll
      for (int blk = 0; blk < 4; ++blk) {
        unsigned lq[16];
#pragma unroll
        for (int t = 0; t < 16; ++t) lq[t] = BUF_LD(rq, loff, (blk * 16 + t) * RB);
#pragma unroll
        for (int t = 0; t < 16; ++t) {
          unsigned lw = lf[blk * 16 + t]; asm volatile("" : "+v"(lw));
          const float l0 = h2f((u16)(lw & 0xffffu)), l1 = h2f((u16)(lw >> 16));
          c0 += l0; c1 += l1;
          const float q0 = __uint_as_float(lq[t] << 16) * fast_exp(c0 - t0), q1 = __uint_as_float(lq[t] & 0xffff0000u) * fast_exp(c1 - t1);
          const float k0 = (1.f - fast_exp(l0)) * fast_exp(t0 - c0), k1 = (1.f - fast_exp(l1)) * fast_exp(t1 - c1);
          BUF_ST(hw_pk_bf16(q0, q1), rq, loff, (blk * 16 + t) * RB);
          BUF_ST(hw_pk_bf16(k0, k1), rq, loff, (blk * 16 + t) * RB + 2048);
        }
      }
    } else {
      const int j = it - 4096; const int grp = j % 12, bc = j / 12, c = bc & 63;
      const int ch = grp * 128 + 2 * lane;
      const __amdgpu_buffer_rsrc_t rx = BUF_RSRC(p.proj + (size_t)(bc * 64) * kNP + 5120 + grp * 128 - (size_t)3 * kNP);
      const __amdgpu_buffer_rsrc_t rh = BUF_RSRC(p.halo + (size_t)bc * 3 * 1536 + grp * 128);
      float w0[4], w1[4];
#pragma unroll
      for (int q = 0; q < 4; ++q) { w0[q] = p.conv_w[q * 1536 + ch]; w1[q] = p.conv_w[q * 1536 + ch + 1]; }
      const float b0 = p.conv_b[ch], b1 = p.conv_b[ch + 1];
      unsigned raw[67];
#pragma unroll
      for (int t = 0; t < 3; ++t) raw[t] = (c > 0) ? BUF_LD(rx, loff, t * RB) : 0u;
#pragma unroll
      for (int t = 0; t < 64; ++t) raw[3 + t] = BUF_LD(rx, loff, (3 + t) * RB);
      float xa[4], xb[4];
#pragma unroll
      for (int q = 0; q < 3; ++q) { xa[q] = __uint_as_float(raw[q] << 16); xb[q] = __uint_as_float(raw[q] & 0xffff0000u); }
#pragma unroll
      for (int t = 0; t < 64; ++t) {
        unsigned rr = raw[t + 3]; asm volatile("" : "+v"(rr));
        xa[3] = __uint_as_float(rr << 16); xb[3] = __uint_as_float(rr & 0xffff0000u);
        float a0 = b0, a1 = b1;
#pragma unroll
        for (int q = 0; q < 4; ++q) { a0 += w0[q] * xa[q]; a1 += w1[q] * xb[q]; }
#pragma unroll
        for (int q = 0; q < 3; ++q) { xa[q] = xa[q + 1]; xb[q] = xb[q + 1]; }
        const unsigned o = hw_pk_bf16(siluf(a0), siluf(a1));
        if (t < 61) BUF_ST(o, rx, loff, (3 + t) * RB);
        else BUF_ST(o, rh, loff, (t - 61) * 3072);
      }
    }
  }
}

typedef __attribute__((address_space(3))) char LDSC;
typedef __attribute__((address_space(3))) float LDSF;
typedef unsigned u32x4v __attribute__((ext_vector_type(4)));
typedef unsigned u32x2v __attribute__((ext_vector_type(2)));
#define BUF_LD128(rs, voff, soff) __builtin_bit_cast(u32x4v, __builtin_amdgcn_raw_buffer_load_b128((rs), (int)(voff), (int)(soff), 0))
#define BUF_ST128(val, rs, voff, soff) __builtin_amdgcn_raw_buffer_store_b128(__builtin_bit_cast(__attribute__((__vector_size__(4 * sizeof(unsigned)))) unsigned, (val)), (rs), (int)(voff), (int)(soff), 0)
#define LDS_U32X4(ptr) (*(__attribute__((address_space(3))) u32x4v*)(ptr))
#define LDS_U32X2(ptr) (*(__attribute__((address_space(3))) u32x2v*)(ptr))
#define LDS_F32X4(ptr) (*(const __attribute__((address_space(3))) f32x4*)(ptr))
__device__ __forceinline__ bf16x8 lds_frag(const LDSC* base, int row, int col, int stride_el) {
  return *(const __attribute__((address_space(3))) bf16x8*)(base + ((row * stride_el + col) << 1));
}
__device__ __forceinline__ unsigned pk_bf16(float lo, float hi) { return hw_pk_bf16(lo, hi); }
__device__ __forceinline__ float bflo(unsigned u) { return __uint_as_float(u << 16); }
__device__ __forceinline__ float bfhi(unsigned u) { return __uint_as_float(u & 0xffff0000u); }
#define MFMA16(a, b, c) __builtin_amdgcn_mfma_f32_16x16x32_bf16((a), (b), (c), 0, 0, 0)

__device__ void hgrn2_fast(const Params& p, int unit, LDSC* sm) {
  const int b = unit >> 4, hh = (unit >> 1) & 7, vh = unit & 1;
  const int tid = opaque_tid(), lane = tid & 63, w = tid >> 6, fr = lane & 15, fq = lane >> 4;
  constexpr int SQ = 136, SS = 72;
  LDSC* Qp = sm; LDSC* Kh = sm + 17408; LDSC* KhT = sm + 34816; LDSC* vT = sm + 53248; LDSC* att = sm + 62464; LDSC* ST = sm + 71680;
  LDSF* dec = (LDSF*)(sm + 89088);
  const u16* pq = p.proj + (size_t)(b * kL) * kNP + hh * 128;
  const int kp = lane, sg = w, crow = tid >> 3, cseg = (tid & 7) * 16;
  const int vp = lane & 31, vg = w * 2 + (lane >> 5);
  const int tt = w >> 1, vb = (w & 1) * 32;
  const int svt = w & 3, skb = (w >> 2) * 4;
  f32x4 S[4];
#pragma unroll
  for (int i = 0; i < 4; ++i) S[i] = (f32x4){0.f, 0.f, 0.f, 0.f};
  u32x4v cq[2], ck[2]; unsigned tk[8], tv[4]; float dv = 0.f;
  constexpr int RB = kNP * 2;
  const int wu = __builtin_amdgcn_readfirstlane(w);
  const __amdgpu_buffer_rsrc_t rq = BUF_RSRC(pq);
  const __amdgpu_buffer_rsrc_t rd = BUF_RSRC(p.dec + (size_t)(b * 64) * 1024 + hh * 128);
  const __amdgpu_buffer_rsrc_t rm = BUF_RSRC(p.mix + (size_t)(b * kL) * 2048 + hh * 128 + vh * 64);
  const int vo_c = (lane >> 3) * RB + cseg * 2;
  const int vo_k = 2048 + kp * 4;
  const int vo_v = (lane >> 5) * 4 * RB + 4096 + vh * 128 + vp * 4;
  const int vo_o = (tt * 16 + fr) * 4096 + vb * 2 + fq * 16;
  auto load_chunk = [&](int c) {
    const int so = (c * 64 + wu * 8) * RB;
    cq[0] = BUF_LD128(rq, vo_c, so); cq[1] = BUF_LD128(rq, vo_c + 16, so); ck[0] = BUF_LD128(rq, vo_c + 2048, so); ck[1] = BUF_LD128(rq, vo_c + 2064, so);
#pragma unroll
    for (int j = 0; j < 8; ++j) tk[j] = BUF_LD(rq, vo_k, so + j * RB);
#pragma unroll
    for (int j = 0; j < 4; ++j) tv[j] = BUF_LD(rq, vo_v, so + j * RB);
    if (tid < 128) dv = __uint_as_float(BUF_LD(rd, tid * 4, c * 4096));
  };
  load_chunk(0);
  for (int c = 0; c < 64; ++c) {
    LDS_U32X4(Qp + ((crow * SQ + cseg) << 1)) = cq[0]; LDS_U32X4(Qp + ((crow * SQ + cseg + 8) << 1)) = cq[1];
    LDS_U32X4(Kh + ((crow * SQ + cseg) << 1)) = ck[0]; LDS_U32X4(Kh + ((crow * SQ + cseg + 8) << 1)) = ck[1];
    {
      u32x4v a, bq;
#pragma unroll
      for (int i = 0; i < 4; ++i) { a[i] = (tk[2 * i] & 0xffffu) | (tk[2 * i + 1] << 16); bq[i] = (tk[2 * i] >> 16) | (tk[2 * i + 1] & 0xffff0000u); }
      LDS_U32X4(KhT + (((2 * kp) * SS + sg * 8) << 1)) = a; LDS_U32X4(KhT + (((2 * kp + 1) * SS + sg * 8) << 1)) = bq;
      u32x2v x0, x1;
#pragma unroll
      for (int i = 0; i < 2; ++i) { x0[i] = (tv[2 * i] & 0xffffu) | (tv[2 * i + 1] << 16); x1[i] = (tv[2 * i] >> 16) | (tv[2 * i + 1] & 0xffff0000u); }
      LDS_U32X2(vT + (((2 * vp) * SS + vg * 4) << 1)) = x0; LDS_U32X2(vT + (((2 * vp + 1) * SS + vg * 4) << 1)) = x1;
    }
    if (tid < 128) dec[tid] = dv;
    if (c + 1 < 64) load_chunk(c + 1);
    __syncthreads();
#pragma unroll
    for (int i = 0; i < 4; ++i) {
      const int kt = skb + i;
      const f32x4 d = LDS_F32X4(dec + kt * 16 + fq * 4);
      S[i] = S[i] * d;
      LDS_U32X2(ST + (((svt * 16 + fr) * SQ + kt * 16 + fq * 4) << 1)) = (u32x2v){pk_bf16(S[i][0], S[i][1]), pk_bf16(S[i][2], S[i][3])};
    }
    {
      const int st0 = (w & 1) * 2;
      f32x4 a2[2]; a2[0] = (f32x4){0.f, 0.f, 0.f, 0.f}; a2[1] = a2[0];
      if (st0 <= tt) {
        bf16x8 Tq[4], K0[4], K1[4];
#pragma unroll
        for (int ks = 0; ks < 4; ++ks) { Tq[ks] = lds_frag(Qp, tt * 16 + fr, ks * 32 + fq * 8, SQ); K0[ks] = lds_frag(Kh, st0 * 16 + fr, ks * 32 + fq * 8, SQ); }
        if (st0 + 1 <= tt) {
#pragma unroll
          for (int ks = 0; ks < 4; ++ks) K1[ks] = lds_frag(Kh, (st0 + 1) * 16 + fr, ks * 32 + fq * 8, SQ);
          __builtin_amdgcn_sched_barrier(0);
#pragma unroll
          for (int ks = 0; ks < 4; ++ks) { a2[0] = MFMA16(K0[ks], Tq[ks], a2[0]); a2[1] = MFMA16(K1[ks], Tq[ks], a2[1]); }
        } else {
          __builtin_amdgcn_sched_barrier(0);
#pragma unroll
          for (int ks = 0; ks < 4; ++ks) a2[0] = MFMA16(K0[ks], Tq[ks], a2[0]);
        }
      }
      const int t = tt * 16 + fr;
#pragma unroll
      for (int i = 0; i < 2; ++i) { const int s0 = (st0 + i) * 16 + fq * 4;
        LDS_U32X2(att + ((t * SS + s0) << 1)) = (u32x2v){pk_bf16(s0 <= t ? a2[i][0] : 0.f, s0 + 1 <= t ? a2[i][1] : 0.f), pk_bf16(s0 + 2 <= t ? a2[i][2] : 0.f, s0 + 3 <= t ? a2[i][3] : 0.f)}; }
    }
    {
      bf16x8 Bv[2], Ak[2][4];
#pragma unroll
      for (int ks = 0; ks < 2; ++ks) { Bv[ks] = lds_frag(vT, svt * 16 + fr, ks * 32 + fq * 8, SS);
#pragma unroll
        for (int i = 0; i < 4; ++i) Ak[ks][i] = lds_frag(KhT, (skb + i) * 16 + fr, ks * 32 + fq * 8, SS); }
      __builtin_amdgcn_sched_barrier(0);
#pragma unroll
      for (int ks = 0; ks < 2; ++ks)
#pragma unroll
        for (int i = 0; i < 4; ++i) S[i] = MFMA16(Ak[ks][i], Bv[ks], S[i]);
    }
    __syncthreads();
    __builtin_amdgcn_s_setprio(1);
    {
      f32x4 o[2];
#pragma unroll
      for (int i = 0; i < 2; ++i) o[i] = (f32x4){0.f, 0.f, 0.f, 0.f};
      const int vrow = vb + (fr >> 2) * 8 + (fr & 3);
      {
        bf16x8 Tq[4], Vs[4][2], Ta[2], Vv[2][2];
#pragma unroll
        for (int ks = 0; ks < 4; ++ks) { Tq[ks] = lds_frag(Qp, tt * 16 + fr, ks * 32 + fq * 8, SQ);
#pragma unroll
          for (int i = 0; i < 2; ++i) Vs[ks][i] = lds_frag(ST, vrow + i * 4, ks * 32 + fq * 8, SQ); }
#pragma unroll
        for (int ks = 0; ks < 2; ++ks) { Ta[ks] = lds_frag(att, tt * 16 + fr, ks * 32 + fq * 8, SS);
#pragma unroll
          for (int i = 0; i < 2; ++i) Vv[ks][i] = lds_frag(vT, vrow + i * 4, ks * 32 + fq * 8, SS); }
        __builtin_amdgcn_sched_barrier(0);
#pragma unroll
        for (int ks = 0; ks < 4; ++ks)
#pragma unroll
          for (int i = 0; i < 2; ++i) o[i] = MFMA16(Vs[ks][i], Tq[ks], o[i]);
#pragma unroll
        for (int ks = 0; ks < 2; ++ks)
#pragma unroll
          for (int i = 0; i < 2; ++i) o[i] = MFMA16(Vv[ks][i], Ta[ks], o[i]);
      }
      __builtin_amdgcn_s_setprio(0);
      u32x4v ow;
      ow[0] = pk_bf16(o[0][0], o[0][1]); ow[1] = pk_bf16(o[0][2], o[0][3]); ow[2] = pk_bf16(o[1][0], o[1][1]); ow[3] = pk_bf16(o[1][2], o[1][3]);
      BUF_ST128(ow, rm, vo_o, c * 64 * 4096);
    }
    __syncthreads();
  }
}

__device__ void phase_cb(const Params& p) {
  const int tid = opaque_tid(), lane = tid & 63, wid = tid >> 6, fr = lane & 15, fq = lane >> 4;
  const int gw = blockIdx.x * (blockDim.x >> 6) + wid, GW = gridDim.x * (blockDim.x >> 6);
  for (int it = gw; it < 1024; it += GW) {
    const int bc = it >> 1, g = it & 1;
    const u16* rowp[4];
#pragma unroll
    for (int q = 0; q < 4; ++q) { const int t = q * 16 + fr;
      rowp[q] = (t < 61) ? p.proj + (size_t)(bc * 64 + t) * kNP + 5120 : p.halo + ((size_t)bc * 3 + (t - 61)) * 1536; }
    f32x4 acc[4][4];
#pragma unroll
    for (int a = 0; a < 4; ++a)
#pragma unroll
      for (int c2 = 0; c2 < 4; ++c2) acc[a][c2] = (f32x4){0.f, 0.f, 0.f, 0.f};
#pragma unroll
    for (int ks = 0; ks < 4; ++ks) {
      bf16x8 Cf[4], Bf[4];
#pragma unroll
      for (int q = 0; q < 4; ++q) { Cf[q] = *(const bf16x8*)(rowp[q] + 1280 + g * 128 + ks * 32 + fq * 8); Bf[q] = *(const bf16x8*)(rowp[q] + 1024 + g * 128 + ks * 32 + fq * 8); }
#pragma unroll
      for (int tt = 0; tt < 4; ++tt)
#pragma unroll
        for (int st = 0; st < 4; ++st) if (st <= tt) acc[tt][st] = MFMA16(Bf[st], Cf[tt], acc[tt][st]);
    }
    float* dst = p.cbb + (size_t)it * 4096;
#pragma unroll
    for (int tt = 0; tt < 4; ++tt)
#pragma unroll
      for (int st = 0; st < 4; ++st) if (st <= tt) *(f32x4*)(dst + (tt * 16 + fr) * 64 + st * 16 + fq * 4) = acc[tt][st];
  }
}

__device__ void mamba2_fast(const Params& p, int unit, LDSC* sm) {
  const int b = unit >> 4, hd = unit & 15, g = hd >> 3;
  const int tid = opaque_tid(), lane = tid & 63, w = tid >> 6, fr = lane & 15, fq = lane >> 4;
  constexpr int SQ = 136, SS = 72;
  LDSC* Cc = sm; LDSC* Bc = sm + 17408; LDSC* BdT = sm + 34816; LDSC* xsT = sm + 53248; LDSC* wl = sm + 62464; LDSC* stT = sm + 71680;
  LDSF* csl = (LDSF*)(sm + 89088); LDSF* dtl_s = (LDSF*)(sm + 89344);
  const float A = -fast_exp(p.a_log[hd]), Dk = p.d_skip[hd];
  const int cp = lane, sg = w, crow = tid >> 3, cseg = (tid & 7) * 16;
  const int xp = lane & 31, xg = w * 2 + (lane >> 5);
  const int chB = 1024 + g * 128, chC = 1280 + g * 128, chX = hd * 64;
  auto xrow = [&](int c, int t) -> const u16* {
    return (t < 61) ? p.proj + (size_t)(b * kL + c * 64 + t) * kNP + 5120 : p.halo + ((size_t)(b * 64 + c) * 3 + (t - 61)) * 1536; };
  f32x4 st[4];
#pragma unroll
  for (int i = 0; i < 4; ++i) st[i] = (f32x4){0.f, 0.f, 0.f, 0.f};
  const int tt = w >> 1, pt = w >> 1, pb = (w & 1) * 32;
  u32x4v cC[2]; unsigned tB[8], tX[4]; float dtl; f32x4 cbv[2];
  const int st0 = (w & 1) * 2;
  constexpr int RB = kNP * 2;
  const int wu = __builtin_amdgcn_readfirstlane(w);
  const __amdgpu_buffer_rsrc_t rw = BUF_RSRC(p.proj);
  const __amdgpu_buffer_rsrc_t rm = BUF_RSRC(p.mix + (size_t)(b * kL) * 2048 + 1024 + hd * 64);
  const int oH = (int)((const char*)p.halo - (const char*)p.proj), oD = (int)((const char*)p.dt - (const char*)p.proj), oC = (int)((const char*)p.cbb - (const char*)p.proj);
  auto xoff0 = [&](int t, int ch) -> int { return (t < 61) ? (((b * kL + t) * kNP + 5120 + ch) * 2) : (oH + ((b * 64 * 3 + (t - 61)) * 1536 + ch) * 2); };
  auto xinc = [&](int t) -> int { return (t < 61) ? 64 * RB : 9216; };
  int vC = xoff0(crow, chC + cseg); const int iC = xinc(crow);
  int vX[4], iX[4];
#pragma unroll
  for (int j = 0; j < 4; ++j) { vX[j] = xoff0(xg * 4 + j, chX + 2 * xp); iX[j] = xinc(xg * 4 + j); }
  int vO = xoff0(tt * 16 + fr, chX + pb + fq * 8); const int iO = xinc(tt * 16 + fr);
  const int vo_z = ((tt * 16 + fr) * kNP + 4096 + hd * 64 + pb + fq * 8) * 2;
  const int vo_cb = ((tt * 16 + fr) * 64 + fq * 4) * 4;
  const int vo_o = (tt * 16 + fr) * 4096 + (pb + fq * 8) * 2;
  auto load_chunk = [&](int c) {
    cC[0] = BUF_LD128(rw, vC, 0); cC[1] = BUF_LD128(rw, vC + 16, 0); vC += iC;
    { const int so = oC + ((b * 64 + c) * 2 + g) * 16384;
      cbv[0] = (st0 <= tt) ? __builtin_bit_cast(f32x4, BUF_LD128(rw, vo_cb + st0 * 64, so)) : (f32x4){0.f, 0.f, 0.f, 0.f};
      cbv[1] = (st0 + 1 <= tt) ? __builtin_bit_cast(f32x4, BUF_LD128(rw, vo_cb + (st0 + 1) * 64, so)) : (f32x4){0.f, 0.f, 0.f, 0.f}; }
#pragma unroll
    for (int j = 0; j < 8; ++j) { const int row = wu * 8 + j;
      const int so = (row < 61) ? (((b * kL + c * 64 + row) * kNP + 5120 + chB) * 2) : (oH + (((b * 64 + c) * 3 + (row - 61)) * 1536 + chB) * 2);
      tB[j] = BUF_LD(rw, cp * 4, so); }
#pragma unroll
    for (int j = 0; j < 4; ++j) { tX[j] = BUF_LD(rw, vX[j], 0); vX[j] += iX[j]; }
    dtl = __uint_as_float(BUF_LD(rw, lane * 64 + hd * 4, oD + (b * kL + c * 64) * 64));
  };
  load_chunk(0);
  const int sgu = __builtin_amdgcn_readfirstlane(w);
  float n_dt, n_cs, n_cl, n_scl;
  auto scan_next = [&]() {
    n_dt = dtl; float cs = n_dt * A;
#pragma unroll
    for (int o2 = 1; o2 < 64; o2 <<= 1) { const float up = __shfl_up(cs, o2); if (lane >= o2) cs += up; }
    n_cs = cs; n_cl = __shfl(cs, 63); n_scl = fast_exp(n_cl - cs) * n_dt;
  };
  scan_next();
  for (int c = 0; c < 64; ++c) {
    const float dtc = n_dt, cs = n_cs, cs_last = n_cl, scl = n_scl;
    const f32x4 cb0 = cbv[0], cb1 = cbv[1];
    if (w == 0) { csl[lane] = cs; dtl_s[lane] = dtc; }
    LDS_U32X4(Cc + ((crow * SQ + cseg) << 1)) = cC[0]; LDS_U32X4(Cc + ((crow * SQ + cseg + 8) << 1)) = cC[1];
    {
      u32x4v d0, d1;
#pragma unroll
      for (int i = 0; i < 4; ++i) {
        const float s0 = __int_as_float(__builtin_amdgcn_readlane(__float_as_int(scl), sgu * 8 + 2 * i)), s1 = __int_as_float(__builtin_amdgcn_readlane(__float_as_int(scl), sgu * 8 + 2 * i + 1));
        d0[i] = pk_bf16(bflo(tB[2 * i]) * s0, bflo(tB[2 * i + 1]) * s1); d1[i] = pk_bf16(bfhi(tB[2 * i]) * s0, bfhi(tB[2 * i + 1]) * s1); }
      LDS_U32X4(BdT + (((2 * cp) * SS + sg * 8) << 1)) = d0; LDS_U32X4(BdT + (((2 * cp + 1) * SS + sg * 8) << 1)) = d1;
      u32x2v x0, x1;
#pragma unroll
      for (int i = 0; i < 2; ++i) { x0[i] = (tX[2 * i] & 0xffffu) | (tX[2 * i + 1] << 16); x1[i] = (tX[2 * i] >> 16) | (tX[2 * i + 1] & 0xffff0000u); }
      LDS_U32X2(xsT + (((2 * xp) * SS + xg * 4) << 1)) = x0; LDS_U32X2(xsT + (((2 * xp + 1) * SS + xg * 4) << 1)) = x1;
    }
    const u32x4v zg = BUF_LD128(rw, vo_z, (b * kL + c * 64) * RB);
    const u32x4v xo = BUF_LD128(rw, vO, 0); vO += iO;
    if (c + 1 < 64) load_chunk(c + 1);
    __syncthreads();
#pragma unroll
    for (int i = 0; i < 4; ++i) { const int nt = (w & 1) * 4 + i;
      LDS_U32X2(stT + (((pt * 16 + fr) * SQ + nt * 16 + fq * 4) << 1)) = (u32x2v){pk_bf16(st[i][0], st[i][1]), pk_bf16(st[i][2], st[i][3])}; }
    const float cst = __shfl(cs, tt * 16 + fr);
    {
      const f32x4 a2[2] = {cb0, cb1};
      const int t = tt * 16 + fr;
#pragma unroll
      for (int i = 0; i < 2; ++i) { const int s0 = (st0 + i) * 16 + fq * 4;
        const f32x4 css = LDS_F32X4(csl + s0), dts = LDS_F32X4(dtl_s + s0);
        float wv[4];
#pragma unroll
        for (int r = 0; r < 4; ++r) wv[r] = (s0 + r <= t) ? a2[i][r] * fast_exp(cst - css[r]) * dts[r] : 0.f;
        LDS_U32X2(wl + ((t * SS + s0) << 1)) = (u32x2v){pk_bf16(wv[0], wv[1]), pk_bf16(wv[2], wv[3])}; }
    }
    {
      const float dk = fast_exp(cs_last);
#pragma unroll
      for (int i = 0; i < 4; ++i) st[i] = st[i] * dk;
#pragma unroll
      for (int ks = 0; ks < 1; ++ks) {
        bf16x8 Bf[2], Af[2][4];
#pragma unroll
        for (int k2 = 0; k2 < 2; ++k2) { Bf[k2] = lds_frag(xsT, pt * 16 + fr, k2 * 32 + fq * 8, SS);
#pragma unroll
          for (int i = 0; i < 4; ++i) Af[k2][i] = lds_frag(BdT, ((w & 1) * 4 + i) * 16 + fr, k2 * 32 + fq * 8, SS); }
        __builtin_amdgcn_sched_barrier(0);
#pragma unroll
        for (int k2 = 0; k2 < 2; ++k2)
#pragma unroll
          for (int i = 0; i < 4; ++i) st[i] = MFMA16(Af[k2][i], Bf[k2], st[i]);
      }
    }
    __syncthreads();
    __builtin_amdgcn_s_setprio(1);
    {
      f32x4 yo[2], yd[2];
#pragma unroll
      for (int i = 0; i < 2; ++i) { yo[i] = (f32x4){0.f, 0.f, 0.f, 0.f}; yd[i] = yo[i]; }
      const int prow = pb + (fr >> 2) * 8 + (fr & 3);
      {
        bf16x8 Tc[4], Ps[4][2], Tw[2], Px[2][2];
#pragma unroll
        for (int ks = 0; ks < 4; ++ks) { Tc[ks] = lds_frag(Cc, tt * 16 + fr, ks * 32 + fq * 8, SQ);
#pragma unroll
          for (int i = 0; i < 2; ++i) Ps[ks][i] = lds_frag(stT, prow + i * 4, ks * 32 + fq * 8, SQ); }
#pragma unroll
        for (int ks = 0; ks < 2; ++ks) { Tw[ks] = lds_frag(wl, tt * 16 + fr, ks * 32 + fq * 8, SS);
#pragma unroll
          for (int i = 0; i < 2; ++i) Px[ks][i] = lds_frag(xsT, prow + i * 4, ks * 32 + fq * 8, SS); }
        __builtin_amdgcn_sched_barrier(0);
#pragma unroll
        for (int ks = 0; ks < 4; ++ks)
#pragma unroll
          for (int i = 0; i < 2; ++i) yo[i] = MFMA16(Ps[ks][i], Tc[ks], yo[i]);
#pragma unroll
        for (int ks = 0; ks < 2; ++ks)
#pragma unroll
          for (int i = 0; i < 2; ++i) yd[i] = MFMA16(Px[ks][i], Tw[ks], yd[i]);
      }
      __builtin_amdgcn_s_setprio(0);
      const float ec = fast_exp(cst);
      const unsigned zw[4] = {zg.x, zg.y, zg.z, zg.w}, xw[4] = {xo.x, xo.y, xo.z, xo.w};
      u32x4v ow;
#pragma unroll
      for (int i = 0; i < 2; ++i) {
        ow[2 * i] = pk_bf16((yd[i][0] + ec * yo[i][0] + Dk * bflo(xw[2 * i])) * bflo(zw[2 * i]), (yd[i][1] + ec * yo[i][1] + Dk * bfhi(xw[2 * i])) * bfhi(zw[2 * i]));
        ow[2 * i + 1] = pk_bf16((yd[i][2] + ec * yo[i][2] + Dk * bflo(xw[2 * i + 1])) * bflo(zw[2 * i + 1]), (yd[i][3] + ec * yo[i][3] + Dk * bfhi(xw[2 * i + 1])) * bfhi(zw[2 * i + 1])); }
      BUF_ST128(ow, rm, vo_o, c * 64 * 4096);
    }
    if (c + 1 < 64) scan_next();
    __syncthreads();
  }
}

__device__ void phase_postnorm(const Params& p) {
  const int tid = opaque_tid(), lane = tid & 63, wid = tid >> 6;
  const int gw = blockIdx.x * (blockDim.x >> 6) + wid, GW = gridDim.x * (blockDim.x >> 6);
  for (int row0 = gw * 2; row0 < kT; row0 += GW * 2) {
    u32x4v raw[2][4], gg[2][2];
#pragma unroll
    for (int r = 0; r < 2; ++r) {
      const u16* mr = p.mix + (size_t)(row0 + r) * 2048 + lane * 8;
#pragma unroll
      for (int q = 0; q < 4; ++q) raw[r][q] = *(const u32x4v*)(mr + q * 512);
      const u16* gr = p.proj + (size_t)(row0 + r) * kNP + 3072 + lane * 8;
      gg[r][0] = __builtin_nontemporal_load((const u32x4v*)gr); gg[r][1] = __builtin_nontemporal_load((const u32x4v*)(gr + 512));
    }
#pragma unroll
    for (int r = 0; r < 2; ++r) {
      u16* mr = p.mix + (size_t)(row0 + r) * 2048 + lane * 8;
#pragma unroll
      for (int q = 0; q < 4; ++q) {
        float v[8]; float ss = 0.f;
#pragma unroll
        for (int i = 0; i < 4; ++i) { v[2 * i] = bflo(raw[r][q][i]); v[2 * i + 1] = bfhi(raw[r][q][i]); ss += v[2 * i] * v[2 * i] + v[2 * i + 1] * v[2 * i + 1]; }
        u32x4v ow;
        if (q < 2) {
          ss += __shfl_xor(ss, 1); ss += __shfl_xor(ss, 2); ss += __shfl_xor(ss, 4); ss += __shfl_xor(ss, 8);
          const float rs = rsqrtf(ss * (1.f / 128.f) + kEps);
          const float* nw = p.hg_nw + q * 512 + lane * 8;
#pragma unroll
          for (int i = 0; i < 4; ++i) ow[i] = hw_pk_bf16(v[2 * i] * rs * nw[2 * i] * bflo(gg[r][q][i]), v[2 * i + 1] * rs * nw[2 * i + 1] * bfhi(gg[r][q][i]));
        } else {
          ss = wave_sum(ss);
          const float rs = rsqrtf(ss * (1.f / 512.f) + kEps);
          const float* nw = p.m2_nw + (q - 2) * 512 + lane * 8;
#pragma unroll
          for (int i = 0; i < 4; ++i) ow[i] = hw_pk_bf16(v[2 * i] * rs * nw[2 * i], v[2 * i + 1] * rs * nw[2 * i + 1]);
        }
        *(u32x4v*)(mr + q * 512) = ow;
      }
    }
  }
}

__device__ void phase_final(const Params& p) {
  const int tid = opaque_tid(), lane = tid & 63, wid = tid >> 6;
  const int gw = blockIdx.x * (blockDim.x >> 6) + wid, GW = gridDim.x * (blockDim.x >> 6);
  for (int row0 = gw * 4; row0 < kT; row0 += GW * 4) {
    float4 v[4][4]; float ss[4];
#pragma unroll
    for (int r = 0; r < 4; ++r) { const float4* xr = (const float4*)(p.xres + (size_t)(row0 + r) * 1024);
#pragma unroll
      for (int i = 0; i < 4; ++i) v[r][i] = xr[i * 64 + lane]; }
#pragma unroll
    for (int r = 0; r < 4; ++r) { float a = 0.f;
#pragma unroll
      for (int i = 0; i < 4; ++i) a += v[r][i].x * v[r][i].x + v[r][i].y * v[r][i].y + v[r][i].z * v[r][i].z + v[r][i].w * v[r][i].w;
      ss[r] = wave_sum(a); }
#pragma unroll
    for (int i = 0; i < 4; ++i) { const float4 w = ((const float4*)p.fin_w)[i * 64 + lane];
#pragma unroll
      for (int r = 0; r < 4; ++r) { const float rs = rsqrtf(ss[r] * (1.f / 1024.f) + kEps);
        float4 o; o.x = v[r][i].x * rs * w.x; o.y = v[r][i].y * rs * w.y; o.z = v[r][i].z * rs * w.z; o.w = v[r][i].w * rs * w.w;
        ((float4*)(p.out + (size_t)(row0 + r) * 1024))[i * 64 + lane] = o; } }
  }
}

#define XB_TMO      128
#define XB_XCNT(j)  (256  + 64 * (j))
#define XB_XSUB(j)  (1280 + 64 * (j))
#define XB_XGEN(j)  (2304 + 64 * (j))
#define XB_TOP      3328
#define XB_TOPGEN   3392
#define XCD_BAR_WORDS 3456
#define XB_SPIN_CAP (1u << 18)
#define LAS __attribute__((address_space(3)))

__device__ __forceinline__ unsigned xb_ld(unsigned* p)              { return __hip_atomic_load(p, __ATOMIC_RELAXED, __HIP_MEMORY_SCOPE_AGENT); }
__device__ __forceinline__ unsigned xb_add(unsigned* p, unsigned v) { return __hip_atomic_fetch_add(p, v, __ATOMIC_RELAXED, __HIP_MEMORY_SCOPE_AGENT); }
__device__ __forceinline__ unsigned xb_xcc_id() { return (unsigned)__builtin_amdgcn_s_getreg((3 << 11) | 20) & 0xFu; }
#define XB_SPIN(cond, bar) do { unsigned _sp = 0; while (cond) { __builtin_amdgcn_s_sleep(1); \
    if ((++_sp & 255u) == 0u) { if (xb_ld(&(bar)[XB_TMO])) break; if (_sp > XB_SPIN_CAP) { atomicAdd(&(bar)[XB_TMO], 1u); break; } } } } while (0)

struct XcdBarrier {
    unsigned* bar; unsigned x;
    volatile LAS unsigned* st;
};

__device__ __forceinline__ XcdBarrier xcd_barrier_post(unsigned* bar, volatile LAS unsigned* st) {
    XcdBarrier b; b.bar = bar; b.x = xb_xcc_id(); b.st = st;
    if (threadIdx.x == 0) (void)xb_add(&bar[XB_XCNT(b.x)], 1u);
    return b;
}
__device__ __forceinline__ void xcd_barrier_complete(unsigned* bar, unsigned x, unsigned& nloc, unsigned& nx) {
    const unsigned G = gridDim.x * gridDim.y * gridDim.z;
    unsigned sum, cnt, mine, sp = 0u;
    for (;;) {
        sum = 0u; cnt = 0u; mine = 0u;
#pragma unroll
        for (unsigned j = 0; j < 16; ++j) { const unsigned c = xb_ld(&bar[XB_XCNT(j)]); sum += c; cnt += (c > 0u) ? 1u : 0u; mine = (j == x) ? c : mine; }
        if (sum == G) break;
        __builtin_amdgcn_s_sleep(1);
        if ((++sp & 255u) == 0u) { if (xb_ld(&bar[XB_TMO])) break; if (sp > XB_SPIN_CAP) { atomicAdd(&bar[XB_TMO], 1u); break; } }
    }
    nloc = mine > 0u ? mine : 1u; nx = cnt > 0u ? cnt : 1u;
}

__device__ __forceinline__ void xcd_barrier(const XcdBarrier& b) {
    asm volatile("s_waitcnt vmcnt(0)" ::: "memory");
    __syncthreads();
    if (threadIdx.x == 0) {
        unsigned* bar = b.bar;
        __builtin_amdgcn_s_waitcnt(0);
        unsigned nloc = b.st[0], nx = b.st[1];
        if (nloc == 0u) { xcd_barrier_complete(bar, b.x, nloc, nx); b.st[0] = nloc; b.st[1] = nx; }
        const unsigned old = xb_add(&bar[XB_XSUB(b.x)], 1u);
        const unsigned gen = old / nloc;
        if (old + 1u == (gen + 1u) * nloc) {
            __builtin_amdgcn_fence(__ATOMIC_RELEASE, "agent");
            asm volatile("s_waitcnt vmcnt(0)" ::: "memory");
            const unsigned og = xb_add(&bar[XB_TOP], 1u);
            const unsigned tg = og / nx;
            if (og + 1u == (tg + 1u) * nx) xb_add(&bar[XB_TOPGEN], 1u);
            else XB_SPIN(xb_ld(&bar[XB_TOPGEN]) == tg, bar);
            __builtin_amdgcn_fence(__ATOMIC_ACQUIRE, "agent");
            xb_add(&bar[XB_XGEN(b.x)], 1u);
            asm volatile("s_waitcnt vmcnt(0)" ::: "memory");
        } else {
            XB_SPIN(xb_ld(&bar[XB_XGEN(b.x)]) == gen, bar);
            __builtin_amdgcn_fence(__ATOMIC_ACQUIRE, "agent");
            asm volatile("s_waitcnt vmcnt(0)" ::: "memory");
        }
    }
    __syncthreads();
}


extern __shared__ __attribute__((aligned(16))) char g_smem[];
constexpr int kThreads = 512;
constexpr size_t kDynLds = 131072 + 16;
__global__ void __launch_bounds__(kThreads, 2) k_mega(Params p) {
  cg::grid_group grid = cg::this_grid();
  volatile LAS unsigned* xst = (volatile LAS unsigned*)((LDSC*)g_smem + 131072);
  if (threadIdx.x < 4) xst[threadIdx.x] = 0u;
  __syncthreads();
  const XcdBarrier xb = xcd_barrier_post(p.bar, xst);
  phase_prep(p, g_smem);
  if (p.use_cg_sync) grid.sync();
  xcd_barrier(xb);
  { Epi1F e{p.proj, p.lb}; pg8::StaticOrder S; S.init(kT, kNP, (int)gridDim.x, (int)blockIdx.x);
    pg8::gemm_phase<Epi1F, pg8::StaticOrder, false>((PG8_LAS unsigned char*)g_smem, pg8::Gemm{p.h, p.Wt1, kT, kNP, 1024}, S, e, nullptr);
    phase_dt(p); }
  xcd_barrier(xb);
  phase_premix(p);
  xcd_barrier(xb);
  phase_cb(p);
  xcd_barrier(xb);
  for (int u = blockIdx.x; u < 256; u += gridDim.x) {
    const int xcd = u & 7, slot = u >> 3;
    if (slot < 16) { const int G = xcd * 2 + (slot >> 3); mamba2_fast(p, (G >> 1) * 16 + (G & 1) * 8 + (slot & 7), (LDSC*)g_smem); }
    else { const int pair = xcd * 8 + ((slot - 16) >> 1); hgrn2_fast(p, pair * 2 + (slot & 1), (LDSC*)g_smem); }
    __syncthreads();
  }
  xcd_barrier(xb);
  phase_postnorm(p);
  xcd_barrier(xb);
  if (gridDim.x == 256) {
    Epi2N e{p.out, p.x, p.fin_w, p.rowss, p.pcnt}; pg8::StaticOrder S; S.init(kT, 1024, (int)gridDim.x, (int)blockIdx.x);
    pg8::gemm_phase<Epi2N, pg8::StaticOrder, false>((PG8_LAS unsigned char*)g_smem, pg8::Gemm{p.mix, p.Wt2, kT, 1024, 2048}, S, e, nullptr);
  } else {
    { Epi2F e{p.xres, p.x}; pg8::StaticOrder S; S.init(kT, 1024, (int)gridDim.x, (int)blockIdx.x);
      pg8::gemm_phase<Epi2F, pg8::StaticOrder, false>((PG8_LAS unsigned char*)g_smem, pg8::Gemm{p.mix, p.Wt2, kT, 1024, 2048}, S, e, nullptr); }
    xcd_barrier(xb);
    phase_final(p);
  }
}

extern "C" void kernel_launch(void* const* d_in, const int* in_sizes, int n_in, void* d_out, int out_size, void* d_ws, size_t ws_size, hipStream_t stream) {
  Params p{};
  p.x = (const float*)d_in[0]; p.norm_w = (const float*)d_in[1]; p.w_in = (const float*)d_in[2]; p.lb_logits = (const float*)d_in[3];
  p.hg_nw = (const float*)d_in[4]; p.conv_w = (const float*)d_in[5]; p.conv_b = (const float*)d_in[6]; p.dt_bias = (const float*)d_in[7];
  p.a_log = (const float*)d_in[8]; p.d_skip = (const float*)d_in[9]; p.m2_nw = (const float*)d_in[10]; p.w_out = (const float*)d_in[11];
  p.fin_w = (const float*)d_in[12];
  p.out = (float*)d_out;
  char* ws = (char*)d_ws; size_t off = 0;
  auto take = [&](size_t bytes) { char* r = ws + off; off += (bytes + 255) & ~(size_t)255; return r; };
  p.proj = (u16*)take((size_t)kT * kNP * 2);
  p.xres = (float*)p.proj;
  p.Wt1 = (u16*)take((size_t)kNIN * 1024 * 2);
  p.Wt2 = (u16*)take((size_t)1024 * 2048 * 2);
  p.dt = (float*)take((size_t)kT * 16 * 4);
  p.lb = (float*)take(1024 * 4);
  p.dec = (float*)take((size_t)8 * 64 * 1024 * 4);
  p.halo = (u16*)take((size_t)8 * 64 * 3 * 1536 * 2);
  p.bar = (unsigned*)take((size_t)XCD_BAR_WORDS * 4);
  p.rowss = (float*)take((size_t)kT * 4);
  p.pcnt = (unsigned*)take(1024);
  p.cbb = (float*)take((size_t)1024 * 4096 * 4);
  p.h = (u16*)d_out;
  p.mix = (u16*)d_out;
  if (off > ws_size) { fprintf(stderr, "workspace too small: need %zu have %zu\n", off, ws_size); return; }
  static int grid_blocks = 0;
  if (!grid_blocks) {
    int dev = 0, cus = 0, per_cu = 0;
    hipGetDevice(&dev);
    hipFuncSetAttribute((const void*)k_mega, hipFuncAttributeMaxDynamicSharedMemorySize, (int)kDynLds);
    hipDeviceGetAttribute(&cus, hipDeviceAttributeMultiprocessorCount, dev);
    hipOccupancyMaxActiveBlocksPerMultiprocessor(&per_cu, k_mega, kThreads, kDynLds);
    if (per_cu > 2) per_cu = 2;
    grid_blocks = cus * per_cu;
  }
  (void)hipMemsetAsync(p.bar, 0, (size_t)XCD_BAR_WORDS * 4 + (size_t)kT * 4 + 1024, stream);
  void* args[] = {&p};
  hipError_t e = hipLaunchCooperativeKernel((void*)k_mega, dim3(grid_blocks), dim3(kThreads), args, kDynLds, stream);
  if (e != hipSuccess) fprintf(stderr, "cooperative launch failed: %s (grid %d)\n", hipGetErrorString(e), grid_blocks);
}
```

```cpp
#include <hip/hip_runtime.h>
#include <hip/hip_cooperative_groups.h>
#include <cstdio>
namespace cg = cooperative_groups;

typedef unsigned short u16;
typedef short bf16x8 __attribute__((ext_vector_type(8)));
typedef float f32x4 __attribute__((ext_vector_type(4)));

constexpr int kT = 32768, kL = 4096;
constexpr int kNP = 6656;
constexpr int kNIN = 6672;
constexpr float kEps = 1e-6f;

typedef __bf16 bf16x2_t __attribute__((ext_vector_type(2)));
typedef float f32x2_t __attribute__((ext_vector_type(2)));
__device__ __forceinline__ unsigned hw_pk_bf16(float lo, float hi) { const f32x2_t v = {lo, hi}; return __builtin_bit_cast(unsigned, __builtin_convertvector(v, bf16x2_t)); }
__device__ __forceinline__ u16 f2bf(float f) { return (u16)(hw_pk_bf16(f, 0.f) & 0xffffu); }
__device__ __forceinline__ float bf2f(u16 b) { return __uint_as_float(((unsigned)b) << 16); }
__device__ __forceinline__ u16 f2h(float f) { _Float16 h = (_Float16)f; return __builtin_bit_cast(u16, h); }
__device__ __forceinline__ float h2f(u16 b) { return (float)__builtin_bit_cast(_Float16, b); }
__device__ __forceinline__ float fast_exp(float x) { return __builtin_amdgcn_exp2f(x * 1.44269504088896f); }
__device__ __forceinline__ float fast_log(float x) { return __builtin_amdgcn_logf(x) * 0.693147180559945f; }
__device__ __forceinline__ float siluf(float v) { return v * __builtin_amdgcn_rcpf(1.f + fast_exp(-v)); }
__device__ __forceinline__ float sigmf(float v) { return __builtin_amdgcn_rcpf(1.f + fast_exp(-v)); }
__device__ __forceinline__ float wave_sum(float v) {
#pragma unroll
  for (int o = 32; o >= 1; o >>= 1) v += __shfl_xor(v, o);
  return v;
}

__device__ __forceinline__ int opaque_tid() { int t = threadIdx.x; asm volatile("" : "+v"(t)); return t; }

struct Params {
  const float* x; const float* norm_w; const float* w_in; const float* lb_logits; const float* hg_nw;
  const float* conv_w; const float* conv_b; const float* dt_bias; const float* a_log; const float* d_skip;
  const float* m2_nw; const float* w_out; const float* fin_w;
  float* out;
  u16* h; u16* Wt1; u16* Wt2; u16* proj; float* dt; u16* mix; float* lb; float* xres; float* dec; u16* halo; unsigned* bar; float* rowss; unsigned* pcnt; float* cbb; int use_cg_sync; int pad0;
};

__device__ void transpose_cvt(const float* src, int K, int N, u16* dst, float* tile  ) {
  const int tid = opaque_tid();
  const int nk = K / 128, nn = (N + 63) / 64;
  for (int t = blockIdx.x; t < nk * nn; t += gridDim.x) {
    const int tk = t % nk, tn = t / nk;
    float v[16];
#pragma unroll
    for (int e = 0; e < 16; ++e) { const int idx = e * 512 + tid, r = idx >> 6, c = idx & 63; const int n = tn * 64 + c;
      v[e] = (n < N) ? __builtin_nontemporal_load(src + (size_t)(tk * 128 + r) * N + n) : 0.f; }
#pragma unroll
    for (int e = 0; e < 16; ++e) { const int idx = e * 512 + tid, r = idx >> 6, c = idx & 63; tile[r * 65 + c] = v[e]; }
    __syncthreads();
#pragma unroll
    for (int e = 0; e < 8; ++e) { const int idx = e * 512 + tid, nr = idx >> 6, kp = idx & 63; const int n = tn * 64 + nr;
      if (n < N) *(unsigned*)(dst + (size_t)n * K + tk * 128 + 2 * kp) = hw_pk_bf16(tile[(2 * kp) * 65 + nr], tile[(2 * kp + 1) * 65 + nr]); }
    __syncthreads();
  }
}

__device__ void phase_prep(const Params& p, char* smem) {
  const int tid = opaque_tid(), lane = tid & 63, wid = tid >> 6;
  const int gt = blockIdx.x * blockDim.x + tid;
  if (gt < 1024) { const float l0 = p.lb_logits[gt], l1 = p.lb_logits[1024 + gt]; p.lb[gt] = 1.f / (1.f + expf(l1 - l0)); }
  transpose_cvt(p.w_in, 1024, kNIN, p.Wt1, (float*)smem);
  transpose_cvt(p.w_out, 2048, 1024, p.Wt2, (float*)smem);
  const int gw = blockIdx.x * (blockDim.x >> 6) + wid, GW = gridDim.x * (blockDim.x >> 6);
  for (int row0 = gw * 4; row0 < kT; row0 += GW * 4) {
    float4 v[4][4]; float ss[4];
#pragma unroll
    for (int r = 0; r < 4; ++r) { const f32x4* xr = (const f32x4*)(p.x + (size_t)(row0 + r) * 1024);
#pragma unroll
      for (int i = 0; i < 4; ++i) { const f32x4 t4 = __builtin_nontemporal_load(xr + i * 64 + lane); v[r][i] = make_float4(t4[0], t4[1], t4[2], t4[3]); } }
#pragma unroll
    for (int r = 0; r < 4; ++r) { float a = 0.f;
#pragma unroll
      for (int i = 0; i < 4; ++i) a += v[r][i].x * v[r][i].x + v[r][i].y * v[r][i].y + v[r][i].z * v[r][i].z + v[r][i].w * v[r][i].w;
      ss[r] = wave_sum(a); }
#pragma unroll
    for (int i = 0; i < 4; ++i) { const float4 w = ((const float4*)p.norm_w)[i * 64 + lane];
#pragma unroll
      for (int r = 0; r < 4; ++r) { const float rs = rsqrtf(ss[r] * (1.f / 1024.f) + kEps);
        uint2 o; o.x = hw_pk_bf16(v[r][i].x * rs * w.x, v[r][i].y * rs * w.y); o.y = hw_pk_bf16(v[r][i].z * rs * w.z, v[r][i].w * rs * w.w);
        *(uint2*)(p.h + (size_t)(row0 + r) * 1024 + (i * 64 + lane) * 4) = o; } }
  }
}

namespace pg8 {
#define PG8_LAS __attribute__((address_space(3)))
typedef unsigned short bf16_t;
typedef short bf16x8 __attribute__((ext_vector_type(8)));
typedef float f32x4 __attribute__((ext_vector_type(4)));
typedef unsigned u32x4 __attribute__((ext_vector_type(4)));
constexpr int BM = 256, BK = 64, HALF = 128, HTB = HALF * BK * 2  , STAGE_BYTES = 8 * HTB, NXCD = 8, WGM = 4;

__host__ __device__ __forceinline__ int lds_byte(int r, int c) { const int st = (r >> 4) * 2 + (c >> 5), rr = r & 15, cc = c & 31, ob = rr * 64 + cc * 2; return st * 1024 + (ob ^ (((ob >> 9) & 1) << 5)); }
__host__ __device__ __forceinline__ void stage_rc(int b, int& R, int& C) { const int st = b / 1024, sb = b % 1024, swz = sb ^ (((sb >> 9) & 1) << 5); R = (st >> 1) * 16 + swz / 64; C = (st & 1) * 32 + (swz % 64) / 2; }
__host__ __device__ __forceinline__ int perm32(int rho) { const int n = rho >> 4, i = rho & 15; return 8 * (i >> 2) + 4 * n + (i & 3); }

struct Unit { int pm, pn; };
struct Gemm { const bf16_t* A; const bf16_t* Bt; int M, N, K; };

struct StaticOrder {
    int nM, nN, nwg, G, c, wg;
    __host__ __device__ void init(int M, int N, int G_, int c_, int wg_ = WGM) { nM = M / BM; nN = N / BM; nwg = nM * nN; G = G_; c = c_; wg = wg_; }
    __host__ __device__ bool next(int i, Unit& u) const {
        const long L = (long)i * G + c; if (L >= nwg) return false;
        int wgid = (int)L; { const int q = nwg / NXCD, r = nwg % NXCD, xcd = wgid % NXCD, off = wgid / NXCD; wgid = (xcd < r ? xcd * (q + 1) : r * (q + 1) + (xcd - r) * q) + off; }
        const int nig = wg * nN, gid = wgid / nig, fm = gid * wg, gsz = (nM - fm) < wg ? (nM - fm) : wg;
        u.pm = fm + ((wgid % nig) % gsz); u.pn = (wgid % nig) / gsz; return true;
    }
    __device__ __forceinline__ void a_ready(const Unit&) const {}
    __device__ __forceinline__ void done(const Unit&) const {}
};
__device__ __forceinline__ unsigned cvt_pk_bf16(float lo, float hi) { return hw_pk_bf16(lo, hi); }
template <class Epi, class Sched, bool STAMP = false>
__device__ __forceinline__ void gemm_phase(PG8_LAS unsigned char* lds, const Gemm g, const Sched& S, const Epi& E, unsigned long long* stamps) {
    const int tid = opaque_tid(), wid = __builtin_amdgcn_readfirstlane(tid >> 6), lane = tid & 63, wr = wid >> 2, wc = wid & 3, fr = lane & 15, fq = lane >> 4;
    const int K = g.K, nt = K / BK;
    int ts_lo = 0, ts_hi = 0, nts = 0; const unsigned long long rt_entry = STAMP ? (unsigned long long)wall_clock64() : 0ull;
#define PG8_STAMP() do { if (STAMP && wid == 0 && nts < 64) { const unsigned long long _c = (unsigned long long)clock64(); \
        ts_lo = (lane == nts) ? (int)(unsigned)_c : ts_lo; ts_hi = (lane == nts) ? (int)(unsigned)(_c >> 32) : ts_hi; ++nts; } } while (0)
    PG8_STAMP();
    unsigned voffA[2], voffB[2];
#pragma unroll
    for (int i = 0; i < 2; ++i) { int R, C; stage_rc(tid * 16 + i * 8192, R, C); const int Rb = Epi::PERM ? ((R & ~31) + perm32(R & 31)) : R;
        voffA[i] = (unsigned)(R * K + C) * 2u; voffB[i] = (unsigned)(Rb * K + C) * 2u; }
    const size_t kstep = (size_t)(BK * 2);
    const size_t hstep = (size_t)HALF * K * 2;
    const size_t tstep = 2 * hstep;
    const unsigned ldsw = (unsigned)wid * 1024u;
    const int aoff = lds_byte(wr * 64 + fr, fq * 8), boff = lds_byte(wc * 32 + fr, fq * 8);
#define PG8_SA(b, h) (((b) * 2 + (h)) * HTB)
#define PG8_SB(b, h) ((4 + (b) * 2 + (h)) * HTB)
#define PG8_STAGE(bufoff, gbase, voff) do { _Pragma("unroll") for (int _i = 0; _i < 2; ++_i) \
        __builtin_amdgcn_global_load_lds((const unsigned*)((const char*)(gbase) + (voff)[_i]), (PG8_LAS unsigned*)(lds + (bufoff) + ldsw + _i * 8192), 16, 0, 0); } while (0)
#define PG8_LDA(dst, b, h) do { _Pragma("unroll") for (int m = 0; m < 4; ++m) _Pragma("unroll") for (int k = 0; k < 2; ++k) dst[m][k] = *(const PG8_LAS bf16x8*)(lds + PG8_SA(b, h) + aoff + m * 2048 + k * 1024); } while (0)
#define PG8_LDB(dst, b, h) do { _Pragma("unroll") for (int n = 0; n < 2; ++n) _Pragma("unroll") for (int k = 0; k < 2; ++k) dst[n][k] = *(const PG8_LAS bf16x8*)(lds + PG8_SB(b, h) + boff + n * 2048 + k * 1024); } while (0)
#define PG8_MMA(ai, bj, At, Bt) do { __builtin_amdgcn_s_setprio(1); _Pragma("unroll") for (int m = 0; m < 4; ++m) _Pragma("unroll") for (int n = 0; n < 2; ++n) _Pragma("unroll") for (int k = 0; k < 2; ++k) \
        acc[ai][bj][m][n] = __builtin_amdgcn_mfma_f32_16x16x32_bf16(Bt[n][k], At[m][k], acc[ai][bj][m][n], 0, 0, 0); __builtin_amdgcn_s_setprio(0); } while (0)
#define PG8_WAIT_V(n) asm volatile("s_waitcnt vmcnt(" #n ")" ::: "memory")
#define PG8_WAIT_L(n) asm volatile("s_waitcnt lgkmcnt(" #n ")" ::: "memory")
#define PG8_BAR __builtin_amdgcn_s_barrier()
#define PG8_SCHED __builtin_amdgcn_sched_barrier(0)
    Unit cur, nxt; int ui = 0;
    if (!S.next(0, cur)) return;
    f32x4 acc[2][2][4][2];
#pragma unroll
    for (int a = 0; a < 2; ++a)
#pragma unroll
        for (int b = 0; b < 2; ++b)
#pragma unroll
            for (int m = 0; m < 4; ++m)
#pragma unroll
                for (int n = 0; n < 2; ++n) acc[a][b][m][n] = (f32x4){0.f, 0.f, 0.f, 0.f};
    bf16x8 At[4][2], B0[2][2], B1[2][2];
    const char* cA = (const char*)g.A + (size_t)cur.pm * tstep; const char* cB = (const char*)g.Bt + (size_t)cur.pn * tstep;
    S.a_ready(cur);
    PG8_STAGE(PG8_SB(0, 0), cB, voffB); PG8_STAGE(PG8_SA(0, 0), cA, voffA); PG8_STAGE(PG8_SB(0, 1), cB + hstep, voffB); PG8_STAGE(PG8_SA(0, 1), cA + hstep, voffA);
    if (wr == 1) PG8_BAR;
    PG8_WAIT_V(4); PG8_BAR;
    PG8_STAGE(PG8_SB(1, 0), cB + kstep, voffB); PG8_STAGE(PG8_SA(1, 0), cA + kstep, voffA); PG8_STAGE(PG8_SB(1, 1), cB + hstep + kstep, voffB);
    PG8_WAIT_V(6); PG8_BAR;
    PG8_STAMP();
    for (;;) {
        const bool has_next = S.next(ui + 1, nxt);
        const char* nA = has_next ? (const char*)g.A + (size_t)nxt.pm * tstep : cA; const char* nB = has_next ? (const char*)g.Bt + (size_t)nxt.pn * tstep : cB;
        for (int t = 0; t < nt; t += 2) {
            const bool last = (t == nt - 2);
            const char* a1 = cA + (size_t)(t + 1) * kstep;
            const char* a2 = last ? nA : cA + (size_t)(t + 2) * kstep; const char* b2 = last ? nB : cB + (size_t)(t + 2) * kstep;
            const char* a3 = a2 + kstep; const char* b3 = b2 + kstep;
            if (last && has_next) S.a_ready(nxt);
            PG8_LDB(B0, 0, 0); PG8_SCHED; PG8_LDA(At, 0, 0); PG8_STAGE(PG8_SA(1, 1), a1 + hstep, voffA);
            PG8_WAIT_L(8); PG8_BAR; PG8_WAIT_L(0); PG8_MMA(0, 0, At, B0); PG8_BAR; PG8_SCHED;
            PG8_LDB(B1, 0, 1); PG8_STAGE(PG8_SB(0, 0), b2, voffB);
            PG8_BAR; PG8_WAIT_L(0); PG8_MMA(0, 1, At, B1); PG8_BAR;
            PG8_LDA(At, 0, 1); PG8_STAGE(PG8_SA(0, 0), a2, voffA);
            PG8_BAR; PG8_WAIT_L(0); PG8_MMA(1, 0, At, B0); PG8_BAR; PG8_SCHED;
            PG8_STAGE(PG8_SB(0, 1), b2 + hstep, voffB);
            PG8_WAIT_V(6); PG8_BAR; PG8_MMA(1, 1, At, B1); PG8_BAR;
            PG8_LDB(B0, 1, 0); PG8_SCHED; PG8_LDA(At, 1, 0); PG8_STAGE(PG8_SA(0, 1), a2 + hstep, voffA);
            PG8_WAIT_L(8); PG8_BAR; PG8_WAIT_L(0); PG8_MMA(0, 0, At, B0); PG8_BAR; PG8_SCHED;
            PG8_LDB(B1, 1, 1); PG8_STAGE(PG8_SB(1, 0), b3, voffB);
            PG8_BAR; PG8_WAIT_L(0); PG8_MMA(0, 1, At, B1); PG8_BAR;
            PG8_LDA(At, 1, 1); PG8_STAGE(PG8_SA(1, 0), a3, voffA);
            PG8_BAR; PG8_WAIT_L(0); PG8_MMA(1, 0, At, B0); PG8_BAR; PG8_SCHED;
            PG8_STAGE(PG8_SB(1, 1), b3 + hstep, voffB);
            PG8_WAIT_V(6); PG8_BAR; PG8_MMA(1, 1, At, B1); PG8_BAR;
        }
        PG8_STAMP();
        if constexpr (!Epi::AFTER_DRAIN) { E(acc, cur, wr, wc, fr, fq); S.done(cur); }
        PG8_STAMP();
        if (!has_next) break;
#pragma unroll
        for (int a = 0; a < 2; ++a)
#pragma unroll
            for (int b = 0; b < 2; ++b)
#pragma unroll
                for (int m = 0; m < 4; ++m)
#pragma unroll
                    for (int n = 0; n < 2; ++n) acc[a][b][m][n] = (f32x4){0.f, 0.f, 0.f, 0.f};
        cur = nxt; cA = nA; cB = nB; ++ui;
    }
    PG8_WAIT_V(0);
    if (wr == 0) PG8_BAR;
    PG8_BAR;
    if constexpr (Epi::AFTER_DRAIN) { E.fused(acc, cur, wr, wc, fr, fq, lds, wid, lane); S.done(cur); }
    PG8_STAMP();
    if (STAMP && wid == 0) { stamps[lane] = lane < nts ? (((unsigned long long)(unsigned)ts_hi << 32) | (unsigned)ts_lo) : 0ull;
        if (lane == 62) stamps[62] = rt_entry; if (lane == 63) stamps[63] = (unsigned long long)wall_clock64(); }
#undef PG8_STAMP
#undef PG8_SA
#undef PG8_SB
#undef PG8_STAGE
#undef PG8_LDA
#undef PG8_LDB
#undef PG8_MMA
#undef PG8_WAIT_V
#undef PG8_WAIT_L
#undef PG8_BAR
#undef PG8_SCHED
}
}

struct Epi1F {
  static constexpr bool PERM = true, AFTER_DRAIN = false;
  u16* proj; const float* lb;
  __device__ __forceinline__ void operator()(const f32x4 (&acc)[2][2][4][2], const pg8::Unit& u, int wr, int wc, int fr, int fq) const {
    const int row0 = u.pm * 256 + wr * 64 + fr, col0 = u.pn * 256 + wc * 32 + 8 * fq;
    const int kind = (u.pn * 256) >> 10;
    f32x4 lbv[2][2];
#pragma unroll
    for (int bj = 0; bj < 2; ++bj)
#pragma unroll
      for (int n = 0; n < 2; ++n) lbv[bj][n] = (kind == 1) ? *(const f32x4*)(lb + (col0 - 1024) + bj * 128 + 4 * n) : (f32x4){0.f, 0.f, 0.f, 0.f};
#pragma unroll
    for (int ai = 0; ai < 2; ++ai)
#pragma unroll
      for (int m = 0; m < 4; ++m) { u16* rowp = proj + (size_t)(row0 + ai * 128 + m * 16) * kNP + col0;
#pragma unroll
        for (int bj = 0; bj < 2; ++bj) { f32x4 v0 = acc[ai][bj][m][0], v1 = acc[ai][bj][m][1];
          pg8::u32x4 w;
          if (kind == 1) {
            unsigned hw[8];
#pragma unroll
            for (int j = 0; j < 4; ++j) { const float l0 = lbv[bj][0][j], l1 = lbv[bj][1][j];
              hw[j] = f2h(fast_log(l0 + (1.f - l0) * sigmf(v0[j]))); hw[4 + j] = f2h(fast_log(l1 + (1.f - l1) * sigmf(v1[j]))); }
            w.x = hw[0] | (hw[1] << 16); w.y = hw[2] | (hw[3] << 16); w.z = hw[4] | (hw[5] << 16); w.w = hw[6] | (hw[7] << 16);
          } else {
            if (kind == 0 || kind == 3 || kind == 4) {
#pragma unroll
              for (int j = 0; j < 4; ++j) { v0[j] = siluf(v0[j]); v1[j] = siluf(v1[j]); } }
            w.x = pg8::cvt_pk_bf16(v0[0], v0[1]); w.y = pg8::cvt_pk_bf16(v0[2], v0[3]); w.z = pg8::cvt_pk_bf16(v1[0], v1[1]); w.w = pg8::cvt_pk_bf16(v1[2], v1[3]);
          }
          __builtin_nontemporal_store(w, (pg8::u32x4*)(rowp + bj * 128)); } }
  }
};
struct Epi2F {
  static constexpr bool PERM = false, AFTER_DRAIN = false;
  float* xres; const float* x;
  __device__ __forceinline__ void operator()(const f32x4 (&acc)[2][2][4][2], const pg8::Unit& u, int wr, int wc, int fr, int fq) const {
    const int row0 = u.pm * 256 + wr * 64 + fr, col0 = u.pn * 256 + wc * 32 + 4 * fq;
#pragma unroll
    for (int ai = 0; ai < 2; ++ai)
#pragma unroll
      for (int m = 0; m < 4; ++m) { const size_t ro = (size_t)(row0 + ai * 128 + m * 16) * 1024 + col0;
#pragma unroll
        for (int bj = 0; bj < 2; ++bj)
#pragma unroll
          for (int n = 0; n < 2; ++n) { const size_t o = ro + bj * 128 + n * 16; const f32x4 xv = *(const f32x4*)(x + o); *(f32x4*)(xres + o) = acc[ai][bj][m][n] + xv; } }
  }
};

struct Epi2N {
  static constexpr bool PERM = false, AFTER_DRAIN = false;
  float* out; const float* x; const float* fw; float* rowss; unsigned* pcnt;
  __device__ __forceinline__ void operator()(const f32x4 (&acc_c)[2][2][4][2], const pg8::Unit& u, int wr, int wc, int fr, int fq) const {
    f32x4 (&acc)[2][2][4][2] = const_cast<f32x4 (&)[2][2][4][2]>(acc_c);
    const int row0 = u.pm * 256 + wr * 64 + fr, col0 = u.pn * 256 + wc * 32 + 4 * fq;
    float ps[8];
#pragma unroll
    for (int ai = 0; ai < 2; ++ai)
#pragma unroll
      for (int m = 0; m < 4; ++m) { const size_t ro = (size_t)(row0 + ai * 128 + m * 16) * 1024 + col0; float sq = 0.f;
#pragma unroll
        for (int bj = 0; bj < 2; ++bj)
#pragma unroll
          for (int n = 0; n < 2; ++n) { const f32x4 xv = __builtin_nontemporal_load((const f32x4*)(x + ro + bj * 128 + n * 16)); const f32x4 v = acc[ai][bj][m][n] + xv; acc[ai][bj][m][n] = v;
            sq += v[0] * v[0] + v[1] * v[1] + v[2] * v[2] + v[3] * v[3]; }
        sq += __shfl_xor(sq, 16); sq += __shfl_xor(sq, 32); ps[ai * 4 + m] = sq; }
#pragma unroll
    for (int k = 0; k < 8; ++k)
      if ((k >> 1) == fq) (void)__hip_atomic_fetch_add(rowss + row0 + (k >> 2) * 128 + (k & 3) * 16, ps[k], __ATOMIC_RELAXED, __HIP_MEMORY_SCOPE_AGENT);
    asm volatile("s_waitcnt vmcnt(0)" ::: "memory");
    unsigned* cnt = pcnt + u.pm * 2 + wr;
    if (fr == 0 && fq == 0) (void)__hip_atomic_fetch_add(cnt, 1u, __ATOMIC_RELAXED, __HIP_MEMORY_SCOPE_AGENT);
    { unsigned spins = 0;
      while (__hip_atomic_load(cnt, __ATOMIC_RELAXED, __HIP_MEMORY_SCOPE_AGENT) < 16u && ++spins < (1u << 22)) __builtin_amdgcn_s_sleep(1); }
    float rs[8];
#pragma unroll
    for (int k = 0; k < 8; ++k) rs[k] = rsqrtf(__hip_atomic_load(rowss + row0 + (k >> 2) * 128 + (k & 3) * 16, __ATOMIC_RELAXED, __HIP_MEMORY_SCOPE_AGENT) * (1.f / 1024.f) + kEps);
    f32x4 wv[2][2];
#pragma unroll
    for (int bj = 0; bj < 2; ++bj)
#pragma unroll
      for (int n = 0; n < 2; ++n) wv[bj][n] = *(const f32x4*)(fw + col0 + bj * 128 + n * 16);
#pragma unroll
    for (int ai = 0; ai < 2; ++ai)
#pragma unroll
      for (int m = 0; m < 4; ++m) { const size_t ro = (size_t)(row0 + ai * 128 + m * 16) * 1024 + col0; const float r = rs[ai * 4 + m];
#pragma unroll
        for (int bj = 0; bj < 2; ++bj)
#pragma unroll
          for (int n = 0; n < 2; ++n) __builtin_nontemporal_store(acc[ai][bj][m][n] * r * wv[bj][n], (f32x4*)(out + ro + bj * 128 + n * 16)); }
  }
};

__device__ __forceinline__ u16 xform1(int c, float v, const float* lb) {
  if (c < 1024) return f2bf(siluf(v));
  if (c < 2048) { const float l = lb[c - 1024]; const float f = l + (1.f - l) * sigmf(v); return f2h(logf(f)); }
  if (c < 3072) return f2bf(v);
  if (c < 5120) return f2bf(siluf(v));
  return f2bf(v);
}
struct Epi1 { u16* proj; const float* lb;
  __device__ __forceinline__ void operator()(int r, int c, float v) const { proj[(size_t)r * kNP + c] = xform1(c, v, lb); } };
struct Epi2 { float* xres; const float* x;
  __device__ __forceinline__ void operator()(int r, int c, float v) const { xres[(size_t)r * 1024 + c] = x[(size_t)r * 1024 + c] + v; } };

template <class Epi>
__device__ void gemm_naive(const u16* A, const u16* Bt, int M, int N, int K, const Epi& epi) {
  const int tid = opaque_tid(), lane = tid & 63, wid = tid >> 6, fr = lane & 15, fq = lane >> 4;
  const int gw = blockIdx.x * (blockDim.x >> 6) + wid, GW = gridDim.x * (blockDim.x >> 6);
  const int nN = N / 32, ntile = (M / 32) * nN;
  for (int t = gw; t < ntile; t += GW) {
    const int m0 = (t / nN) * 32, n0 = (t % nN) * 32;
    f32x4 acc[2][2];
#pragma unroll
    for (int i = 0; i < 2; ++i)
#pragma unroll
      for (int j = 0; j < 2; ++j) acc[i][j] = (f32x4){0.f, 0.f, 0.f, 0.f};
    for (int k0 = 0; k0 < K; k0 += 32) {
      bf16x8 a[2], b[2];
#pragma unroll
      for (int i = 0; i < 2; ++i) a[i] = *(const bf16x8*)(A + (size_t)(m0 + i * 16 + fr) * K + k0 + fq * 8);
#pragma unroll
      for (int j = 0; j < 2; ++j) b[j] = *(const bf16x8*)(Bt + (size_t)(n0 + j * 16 + fr) * K + k0 + fq * 8);
#pragma unroll
      for (int i = 0; i < 2; ++i)
#pragma unroll
        for (int j = 0; j < 2; ++j) acc[i][j] = __builtin_amdgcn_mfma_f32_16x16x32_bf16(a[i], b[j], acc[i][j], 0, 0, 0);
    }
#pragma unroll
    for (int i = 0; i < 2; ++i)
#pragma unroll
      for (int j = 0; j < 2; ++j)
#pragma unroll
        for (int r = 0; r < 4; ++r) epi(m0 + i * 16 + fq * 4 + r, n0 + j * 16 + fr, acc[i][j][r]);
  }
}

__device__ void phase_dt(const Params& p) {
  const int tid = opaque_tid(), lane = tid & 63, wid = tid >> 6, fr = lane & 15, fq = lane >> 4;
  const int gw = blockIdx.x * (blockDim.x >> 6) + wid, GW = gridDim.x * (blockDim.x >> 6);
  for (int t = gw; t < kT / 16; t += GW) {
    const int m0 = t * 16;
    f32x4 acc = (f32x4){0.f, 0.f, 0.f, 0.f};
    for (int k0 = 0; k0 < 1024; k0 += 32) {
      const bf16x8 a = *(const bf16x8*)(p.h + (size_t)(m0 + fr) * 1024 + k0 + fq * 8);
      const bf16x8 b = *(const bf16x8*)(p.Wt1 + (size_t)(kNP + fr) * 1024 + k0 + fq * 8);
      acc = __builtin_amdgcn_mfma_f32_16x16x32_bf16(a, b, acc, 0, 0, 0);
    }
    const float bias = p.dt_bias[fr];
#pragma unroll
    for (int r = 0; r < 4; ++r) { const float v = acc[r] + bias; const float sp = v > 20.f ? v : log1pf(expf(v));
      p.dt[(size_t)(m0 + fq * 4 + r) * 16 + fr] = sp; }
  }
}

__device__ void hgrn2_naive(const Params& p, int unit, char* smem) {
  const int b = unit >> 3, hh = unit & 7;
  const int tid = opaque_tid(), v = tid & 127, kq = tid >> 7;
  float S[32];
#pragma unroll
  for (int i = 0; i < 32; ++i) S[i] = 0.f;
  float* sq = (float*)smem; float* sf = sq + 2048; float* sk = sf + 2048; float* sv = sk + 2048; float* sp = sv + 2048;
  for (int t0 = 0; t0 < kL; t0 += 16) {
    for (int i = tid; i < 2048; i += 512) { const int tt = i >> 7, c = i & 127; const size_t row = (size_t)(b * kL + t0 + tt) * kNP;
      sq[i] = bf2f(p.proj[row + hh * 128 + c]);
      const float f = fast_exp(h2f(p.proj[row + 1024 + hh * 128 + c])); sf[i] = f; sk[i] = 1.f - f;
      sv[i] = bf2f(p.proj[row + 2048 + hh * 128 + c]); }
    __syncthreads();
    for (int tt = 0; tt < 16; ++tt) { const float vv = sv[tt * 128 + v]; float acc = 0.f;
#pragma unroll
      for (int i = 0; i < 32; ++i) { const int k = kq * 32 + i; S[i] = sf[tt * 128 + k] * S[i] + sk[tt * 128 + k] * vv; acc += S[i] * sq[tt * 128 + k]; }
      sp[(kq * 16 + tt) * 128 + v] = acc; }
    __syncthreads();
    { const int tt = tid >> 5, l32 = tid & 31; float o[4]; float ss = 0.f;
#pragma unroll
      for (int j = 0; j < 4; ++j) { const int vv = l32 + 32 * j; o[j] = sp[(0 * 16 + tt) * 128 + vv] + sp[(1 * 16 + tt) * 128 + vv] + sp[(2 * 16 + tt) * 128 + vv] + sp[(3 * 16 + tt) * 128 + vv]; ss += o[j] * o[j]; }
#pragma unroll
      for (int off = 16; off >= 1; off >>= 1) ss += __shfl_xor(ss, off);
      const float rs = rsqrtf(ss * (1.f / 128.f) + kEps);
      const size_t row = (size_t)(b * kL + t0 + tt);
#pragma unroll
      for (int j = 0; j < 4; ++j) { const int vv = l32 + 32 * j; const float g = bf2f(p.proj[row * kNP + 3072 + hh * 128 + vv]);
        p.mix[row * 2048 + hh * 128 + vv] = f2bf(o[j] * rs * p.hg_nw[hh * 128 + vv] * g); } }
  }
}

__device__ void mamba2_naive(const Params& p, int unit, char* smem) {
  const int b = unit >> 4, hd = unit & 15, g = hd >> 3;
  const int tid = opaque_tid(), pp = tid & 63, nq = tid >> 6;
  float st[16];
#pragma unroll
  for (int i = 0; i < 16; ++i) st[i] = 0.f;
  const float A = -fast_exp(p.a_log[hd]), Dk = p.d_skip[hd];
  float* sx = (float*)smem; float* sB = sx + 16 * 64; float* sC = sB + 16 * 128; float* sdt = sC + 16 * 128; float* sp = sdt + 16;
  for (int t0 = 0; t0 < kL; t0 += 16) {
    for (int i = tid; i < 5120; i += 512) { const int tt = i / 320, c = i % 320;
      const int ch = c < 64 ? hd * 64 + c : (c < 192 ? 1024 + g * 128 + (c - 64) : 1280 + g * 128 + (c - 192));
      float acc = p.conv_b[ch];
#pragma unroll
      for (int j = 0; j < 4; ++j) { const int ts = t0 + tt - 3 + j; if (ts >= 0) acc += p.conv_w[j * 1536 + ch] * bf2f(p.proj[(size_t)(b * kL + ts) * kNP + 5120 + ch]); }
      acc = siluf(acc);
      if (c < 64) sx[tt * 64 + c] = acc; else if (c < 192) sB[tt * 128 + c - 64] = acc; else sC[tt * 128 + c - 192] = acc; }
    if (tid < 16) sdt[tid] = p.dt[(size_t)(b * kL + t0 + tid) * 16 + hd];
    __syncthreads();
    for (int tt = 0; tt < 16; ++tt) { const float dt = sdt[tt], dA = fast_exp(dt * A), dx = dt * sx[tt * 64 + pp]; float acc = 0.f;
#pragma unroll
      for (int i = 0; i < 16; ++i) { const int n = nq * 16 + i; st[i] = dA * st[i] + dx * sB[tt * 128 + n]; acc += st[i] * sC[tt * 128 + n]; }
      sp[(nq * 16 + tt) * 64 + pp] = acc; }
    __syncthreads();
    for (int i = tid; i < 1024; i += 512) { const int tt = i >> 6, q = i & 63; float y = Dk * sx[tt * 64 + q];
#pragma unroll
      for (int r = 0; r < 8; ++r) y += sp[(r * 16 + tt) * 64 + q];
      const size_t row = (size_t)(b * kL + t0 + tt); const float z = bf2f(p.proj[row * kNP + 4096 + hd * 64 + q]);
      p.mix[row * 2048 + 1024 + hd * 64 + q] = f2bf(y * z); }
    __syncthreads();
  }
}

#define BUF_RSRC(ptr) __builtin_amdgcn_make_buffer_rsrc((void*)(ptr), 0, 0x7fffffff, 0x00020000)
#define BUF_LD(rs, voff, soff) ((unsigned)__builtin_amdgcn_raw_buffer_load_b32((rs), (int)(voff), (int)(soff), 0))
#define BUF_ST(val, rs, voff, soff) __builtin_amdgcn_raw_buffer_store_b32((unsigned)(val), (rs), (int)(voff), (int)(soff), 0)
__device__ void phase_premix(const Params& p) {
  const int tid = opaque_tid(), lane = tid & 63, wid = __builtin_amdgcn_readfirstlane(tid >> 6);
  const int gw = blockIdx.x * (blockDim.x >> 6) + wid, GW = gridDim.x * (blockDim.x >> 6);
  const int loff = lane * 4;
  constexpr int RB = kNP * 2;
  for (int it = gw; it < 4096 + 6144; it += GW) {
    if (it < 4096) {
      const int hh = it & 7, bc = it >> 3;
      const __amdgpu_buffer_rsrc_t rq = BUF_RSRC(p.proj + (size_t)(bc * 64) * kNP + hh * 128);
      unsigned lf[64];
#pragma unroll
      for (int t = 0; t < 64; ++t) lf[t] = BUF_LD(rq, loff, t * RB + 2048);
      float t0 = 0.f, t1 = 0.f;
#pragma unroll
      for (int t = 0; t < 64; ++t) { t0 += h2f((u16)(lf[t] & 0xffffu)); t1 += h2f((u16)(lf[t] >> 16)); }
      float2 dv; dv.x = fast_exp(t0); dv.y = fast_exp(t1);
      *(float2*)(p.dec + (size_t)bc * 1024 + hh * 128 + 2 * lane) = dv;
      float c0 = 0.f, c1 = 0.f;
#pragma unroll
      for (int blk = 0; blk < 4; ++blk) {
        unsigned lq[16];
#pragma unroll
        for (int t = 0; t < 16; ++t) lq[t] = BUF_LD(rq, loff, (blk * 16 + t) * RB);
#pragma unroll
        for (int t = 0; t < 16; ++t) {
          unsigned lw = lf[blk * 16 + t]; asm volatile("" : "+v"(lw));
          const float l0 = h2f((u16)(lw & 0xffffu)), l1 = h2f((u16)(lw >> 16));
          c0 += l0; c1 += l1;
          const float q0 = __uint_as_float(lq[t] << 16) * fast_exp(c0 - t0), q1 = __uint_as_float(lq[t] & 0xffff0000u) * fast_exp(c1 - t1);
          const float k0 = (1.f - fast_exp(l0)) * fast_exp(t0 - c0), k1 = (1.f - fast_exp(l1)) * fast_exp(t1 - c1);
          BUF_ST(hw_pk_bf16(q0, q1), rq, loff, (blk * 16 + t) * RB);
          BUF_ST(hw_pk_bf16(k0, k1), rq, loff, (blk * 16 + t) * RB + 2048);
        }
      }
    } else {
      const int j = it - 4096; const int grp = j % 12, bc = j / 12, c = bc & 63;
      const int ch = grp * 128 + 2 * lane;
      const __amdgpu_buffer_rsrc_t rx = BUF_RSRC(p.proj + (size_t)(bc * 64) * kNP + 5120 + grp * 128 - (size_t)3 * kNP);
      const __amdgpu_buffer_rsrc_t rh = BUF_RSRC(p.halo + (size_t)bc * 3 * 1536 + grp * 128);
      float w0[4], w1[4];
#pragma unroll
      for (int q = 0; q < 4; ++q) { w0[q] = p.conv_w[q * 1536 + ch]; w1[q] = p.conv_w[q * 1536 + ch + 1]; }
      const float b0 = p.conv_b[ch], b1 = p.conv_b[ch + 1];
      unsigned raw[67];
#pragma unroll
      for (int t = 0; t < 3; ++t) raw[t] = (c > 0) ? BUF_LD(rx, loff, t * RB) : 0u;
#pragma unroll
      for (int t = 0; t < 64; ++t) raw[3 + t] = BUF_LD(rx, loff, (3 + t) * RB);
      float xa[4], xb[4];
#pragma unroll
      for (int q = 0; q < 3; ++q) { xa[q] = __uint_as_float(raw[q] << 16); xb[q] = __uint_as_float(raw[q] & 0xffff0000u); }
#pragma unroll
      for (int t = 0; t < 64; ++t) {
        unsigned rr = raw[t + 3]; asm volatile("" : "+v"(rr));
        xa[3] = __uint_as_float(rr << 16); xb[3] = __uint_as_float(rr & 0xffff0000u);
        float a0 = b0, a1 = b1;
#pragma unroll
        for (int q = 0; q < 4; ++q) { a0 += w0[q] * xa[q]; a1 += w1[q] * xb[q]; }
#pragma unroll
        for (int q = 0; q < 3; ++q) { xa[q] = xa[q + 1]; xb[q] = xb[q + 1]; }
        const unsigned o = hw_pk_bf16(siluf(a0), siluf(a1));
        if (t < 61) BUF_ST(o, rx, loff, (3 + t) * RB);
        else BUF_ST(o, rh, loff, (t - 61) * 3072);
      }
    }
  }
}

typedef __attribute__((address_space(3))) char LDSC;
typedef __attribute__((address_space(3))) float LDSF;
typedef unsigned u32x4v __attribute__((ext_vector_type(4)));
typedef unsigned u32x2v __attribute__((ext_vector_type(2)));
#define BUF_LD128(rs, voff, soff) __builtin_bit_cast(u32x4v, __builtin_amdgcn_raw_buffer_load_b128((rs), (int)(voff), (int)(soff), 0))
#define BUF_ST128(val, rs, voff, soff) __builtin_amdgcn_raw_buffer_store_b128(__builtin_bit_cast(__attribute__((__vector_size__(4 * sizeof(unsigned)))) unsigned, (val)), (rs), (int)(voff), (int)(soff), 0)
#define LDS_U32X4(ptr) (*(__attribute__((address_space(3))) u32x4v*)(ptr))
#define LDS_U32X2(ptr) (*(__attribute__((address_space(3))) u32x2v*)(ptr))
#define LDS_F32X4(ptr) (*(const __attribute__((address_space(3))) f32x4*)(ptr))
__device__ __forceinline__ bf16x8 lds_frag(const LDSC* base, int row, int col, int stride_el) {
  return *(const __attribute__((address_space(3))) bf16x8*)(base + ((row * stride_el + col) << 1));
}
__device__ __forceinline__ unsigned pk_bf16(float lo, float hi) { return hw_pk_bf16(lo, hi); }
__device__ __forceinline__ float bflo(unsigned u) { return __uint_as_float(u << 16); }
__device__ __forceinline__ float bfhi(unsigned u) { return __uint_as_float(u & 0xffff0000u); }
#define MFMA16(a, b, c) __builtin_amdgcn_mfma_f32_16x16x32_bf16((a), (b), (c), 0, 0, 0)

__device__ void hgrn2_fast(const Params& p, int unit, LDSC* sm) {
  const int b = unit >> 4, hh = (unit >> 1) & 7, vh = unit & 1;
  const int tid = opaque_tid(), lane = tid & 63, w = tid >> 6, fr = lane & 15, fq = lane >> 4;
  constexpr int SQ = 136, SS = 72;
  LDSC* Qp = sm; LDSC* Kh = sm + 17408; LDSC* KhT = sm + 34816; LDSC* vT = sm + 53248; LDSC* att = sm + 62464; LDSC* ST = sm + 71680;
  LDSF* dec = (LDSF*)(sm + 89088);
  const u16* pq = p.proj + (size_t)(b * kL) * kNP + hh * 128;
  const int kp = lane, sg = w, crow = tid >> 3, cseg = (tid & 7) * 16;
  const int vp = lane & 31, vg = w * 2 + (lane >> 5);
  const int tt = w >> 1, vb = (w & 1) * 32;
  const int svt = w & 3, skb = (w >> 2) * 4;
  f32x4 S[4];
#pragma unroll
  for (int i = 0; i < 4; ++i) S[i] = (f32x4){0.f, 0.f, 0.f, 0.f};
  u32x4v cq[2], ck[2]; unsigned tk[8], tv[4]; float dv = 0.f;
  constexpr int RB = kNP * 2;
  const int wu = __builtin_amdgcn_readfirstlane(w);
  const __amdgpu_buffer_rsrc_t rq = BUF_RSRC(pq);
  const __amdgpu_buffer_rsrc_t rd = BUF_RSRC(p.dec + (size_t)(b * 64) * 1024 + hh * 128);
  const __amdgpu_buffer_rsrc_t rm = BUF_RSRC(p.mix + (size_t)(b * kL) * 2048 + hh * 128 + vh * 64);
  const int vo_c = (lane >> 3) * RB + cseg * 2;
  const int vo_k = 2048 + kp * 4;
  const int vo_v = (lane >> 5) * 4 * RB + 4096 + vh * 128 + vp * 4;
  const int vo_o = (tt * 16 + fr) * 4096 + vb * 2 + fq * 16;
  auto load_chunk = [&](int c) {
    const int so = (c * 64 + wu * 8) * RB;
    cq[0] = BUF_LD128(rq, vo_c, so); cq[1] = BUF_LD128(rq, vo_c + 16, so); ck[0] = BUF_LD128(rq, vo_c + 2048, so); ck[1] = BUF_LD128(rq, vo_c + 2064, so);
#pragma unroll
    for (int j = 0; j < 8; ++j) tk[j] = BUF_LD(rq, vo_k, so + j * RB);
#pragma unroll
    for (int j = 0; j < 4; ++j) tv[j] = BUF_LD(rq, vo_v, so + j * RB);
    if (tid < 128) dv = __uint_as_float(BUF_LD(rd, tid * 4, c * 4096));
  };
  load_chunk(0);
  for (int c = 0; c < 64; ++c) {
    LDS_U32X4(Qp + ((crow * SQ + cseg) << 1)) = cq[0]; LDS_U32X4(Qp + ((crow * SQ + cseg + 8) << 1)) = cq[1];
    LDS_U32X4(Kh + ((crow * SQ + cseg) << 1)) = ck[0]; LDS_U32X4(Kh + ((crow * SQ + cseg + 8) << 1)) = ck[1];
    {
      u32x4v a, bq;
#pragma unroll
      for (int i = 0; i < 4; ++i) { a[i] = (tk[2 * i] & 0xffffu) | (tk[2 * i + 1] << 16); bq[i] = (tk[2 * i] >> 16) | (tk[2 * i + 1] & 0xffff0000u); }
      LDS_U32X4(KhT + (((2 * kp) * SS + sg * 8) << 1)) = a; LDS_U32X4(KhT + (((2 * kp + 1) * SS + sg * 8) << 1)) = bq;
      u32x2v x0, x1;
#pragma unroll
      for (int i = 0; i < 2; ++i) { x0[i] = (tv[2 * i] & 0xffffu) | (tv[2 * i + 1] << 16); x1[i] = (tv[2 * i] >> 16) | (tv[2 * i + 1] & 0xffff0000u); }
      LDS_U32X2(vT + (((2 * vp) * SS + vg * 4) << 1)) = x0; LDS_U32X2(vT + (((2 * vp + 1) * SS + vg * 4) << 1)) = x1;
    }
    if (tid < 128) dec[tid] = dv;
    if (c + 1 < 64) load_chunk(c + 1);
    __syncthreads();
#pragma unroll
    for (int i = 0; i < 4; ++i) {
      const int kt = skb + i;
      const f32x4 d = LDS_F32X4(dec + kt * 16 + fq * 4);
      S[i] = S[i] * d;
      LDS_U32X2(ST + (((svt * 16 + fr) * SQ + kt * 16 + fq * 4) << 1)) = (u32x2v){pk_bf16(S[i][0], S[i][1]), pk_bf16(S[i][2], S[i][3])};
    }
    {
      const int st0 = (w & 1) * 2;
      f32x4 a2[2]; a2[0] = (f32x4){0.f, 0.f, 0.f, 0.f}; a2[1] = a2[0];
      if (st0 <= tt) {
        bf16x8 Tq[4], K0[4], K1[4];
#pragma unroll
        for (int ks = 0; ks < 4; ++ks) { Tq[ks] = lds_frag(Qp, tt * 16 + fr, ks * 32 + fq * 8, SQ); K0[ks] = lds_frag(Kh, st0 * 16 + fr, ks * 32 + fq * 8, SQ); }
        if (st0 + 1 <= tt) {
#pragma unroll
          for (int ks = 0; ks < 4; ++ks) K1[ks] = lds_frag(Kh, (st0 + 1) * 16 + fr, ks * 32 + fq * 8, SQ);
          __builtin_amdgcn_sched_barrier(0);
#pragma unroll
          for (int ks = 0; ks < 4; ++ks) { a2[0] = MFMA16(K0[ks], Tq[ks], a2[0]); a2[1] = MFMA16(K1[ks], Tq[ks], a2[1]); }
        } else {
          __builtin_amdgcn_sched_barrier(0);
#pragma unroll
          for (int ks = 0; ks < 4; ++ks) a2[0] = MFMA16(K0[ks], Tq[ks], a2[0]);
        }
      }
      const int t = tt * 16 + fr;
#pragma unroll
      for (int i = 0; i < 2; ++i) { const int s0 = (st0 + i) * 16 + fq * 4;
        LDS_U32X2(att + ((t * SS + s0) << 1)) = (u32x2v){pk_bf16(s0 <= t ? a2[i][0] : 0.f, s0 + 1 <= t ? a2[i][1] : 0.f), pk_bf16(s0 + 2 <= t ? a2[i][2] : 0.f, s0 + 3 <= t ? a2[i][3] : 0.f)}; }
    }
    {
      bf16x8 Bv[2], Ak[2][4];
#pragma unroll
      for (int ks = 0; ks < 2; ++ks) { Bv[ks] = lds_frag(vT, svt * 16 + fr, ks * 32 + fq * 8, SS);
#pragma unroll
        for (int i = 0; i < 4; ++i) Ak[ks][i] = lds_frag(KhT, (skb + i) * 16 + fr, ks * 32 + fq * 8, SS); }
      __builtin_amdgcn_sched_barrier(0);
#pragma unroll
      for (int ks = 0; ks < 2; ++ks)
#pragma unroll
        for (int i = 0; i < 4; ++i) S[i] = MFMA16(Ak[ks][i], Bv[ks], S[i]);
    }
    __syncthreads();
    __builtin_amdgcn_s_setprio(1);
    {
      f32x4 o[2];
#pragma unroll
      for (int i = 0; i < 2; ++i) o[i] = (f32x4){0.f, 0.f, 0.f, 0.f};
      const int vrow = vb + (fr >> 2) * 8 + (fr & 3);
      {
        bf16x8 Tq[4], Vs[4][2], Ta[2], Vv[2][2];
#pragma unroll
        for (int ks = 0; ks < 4; ++ks) { Tq[ks] = lds_frag(Qp, tt * 16 + fr, ks * 32 + fq * 8, SQ);
#pragma unroll
          for (int i = 0; i < 2; ++i) Vs[ks][i] = lds_frag(ST, vrow + i * 4, ks * 32 + fq * 8, SQ); }
#pragma unroll
        for (int ks = 0; ks < 2; ++ks) { Ta[ks] = lds_frag(att, tt * 16 + fr, ks * 32 + fq * 8, SS);
#pragma unroll
          for (int i = 0; i < 2; ++i) Vv[ks][i] = lds_frag(vT, vrow + i * 4, ks * 32 + fq * 8, SS); }
        __builtin_amdgcn_sched_barrier(0);
#pragma unroll
        for (int ks = 0; ks < 4; ++ks)
#pragma unroll
          for (int i = 0; i < 2; ++i) o[i] = MFMA16(Vs[ks][i], Tq[ks], o[i]);
#pragma unroll
        for (int ks = 0; ks < 2; ++ks)
#pragma unroll
          for (int i = 0; i < 2; ++i) o[i] = MFMA16(Vv[ks][i], Ta[ks], o[i]);
      }
      __builtin_amdgcn_s_setprio(0);
      u32x4v ow;
      ow[0] = pk_bf16(o[0][0], o[0][1]); ow[1] = pk_bf16(o[0][2], o[0][3]); ow[2] = pk_bf16(o[1][0], o[1][1]); ow[3] = pk_bf16(o[1][2], o[1][3]);
      BUF_ST128(ow, rm, vo_o, c * 64 * 4096);
    }
    __syncthreads();
  }
}

__device__ void phase_cb(const Params& p) {
  const int tid = opaque_tid(), lane = tid & 63, wid = tid >> 6, fr = lane & 15, fq = lane >> 4;
  const int gw = blockIdx.x * (blockDim.x >> 6) + wid, GW = gridDim.x * (blockDim.x >> 6);
  for (int it = gw; it < 1024; it += GW) {
    const int bc = it >> 1, g = it & 1;
    const u16* rowp[4];
#pragma unroll
    for (int q = 0; q < 4; ++q) { const int t = q * 16 + fr;
      rowp[q] = (t < 61) ? p.proj + (size_t)(bc * 64 + t) * kNP + 5120 : p.halo + ((size_t)bc * 3 + (t - 61)) * 1536; }
    f32x4 acc[4][4];
#pragma unroll
    for (int a = 0; a < 4; ++a)
#pragma unroll
      for (int c2 = 0; c2 < 4; ++c2) acc[a][c2] = (f32x4){0.f, 0.f, 0.f, 0.f};
#pragma unroll
    for (int ks = 0; ks < 4; ++ks) {
      bf16x8 Cf[4], Bf[4];
#pragma unroll
      for (int q = 0; q < 4; ++q) { Cf[q] = *(const bf16x8*)(rowp[q] + 1280 + g * 128 + ks * 32 + fq * 8); Bf[q] = *(const bf16x8*)(rowp[q] + 1024 + g * 128 + ks * 32 + fq * 8); }
#pragma unroll
      for (int tt = 0; tt < 4; ++tt)
#pragma unroll
        for (int st = 0; st < 4; ++st) if (st <= tt) acc[tt][st] = MFMA16(Bf[st], Cf[tt], acc[tt][st]);
    }
    float* dst = p.cbb + (size_t)it * 4096;
#pragma unroll
    for (int tt = 0; tt < 4; ++tt)
#pragma unroll
      for (int st = 0; st < 4; ++st) if (st <= tt) *(f32x4*)(dst + (tt * 16 + fr) * 64 + st * 16 + fq * 4) = acc[tt][st];
  }
}

__device__ void mamba2_fast(const Params& p, int unit, LDSC* sm) {
  const int b = unit >> 4, hd = unit & 15, g = hd >> 3;
  const int tid = opaque_tid(), lane = tid & 63, w = tid >> 6, fr = lane & 15, fq = lane >> 4;
  constexpr int SQ = 136, SS = 72;
  LDSC* Cc = sm; LDSC* Bc = sm + 17408; LDSC* BdT = sm + 34816; LDSC* xsT = sm + 53248; LDSC* wl = sm + 62464; LDSC* stT = sm + 71680;
  LDSF* csl = (LDSF*)(sm + 89088); LDSF* dtl_s = (LDSF*)(sm + 89344);
  const float A = -fast_exp(p.a_log[hd]), Dk = p.d_skip[hd];
  const int cp = lane, sg = w, crow = tid >> 3, cseg = (tid & 7) * 16;
  const int xp = lane & 31, xg = w * 2 + (lane >> 5);
  const int chB = 1024 + g * 128, chC = 1280 + g * 128, chX = hd * 64;
  auto xrow = [&](int c, int t) -> const u16* {
    return (t < 61) ? p.proj + (size_t)(b * kL + c * 64 + t) * kNP + 5120 : p.halo + ((size_t)(b * 64 + c) * 3 + (t - 61)) * 1536; };
  f32x4 st[4];
#pragma unroll
  for (int i = 0; i < 4; ++i) st[i] = (f32x4){0.f, 0.f, 0.f, 0.f};
  const int tt = w >> 1, pt = w >> 1, pb = (w & 1) * 32;
  u32x4v cC[2]; unsigned tB[8], tX[4]; float dtl; f32x4 cbv[2];
  const int st0 = (w & 1) * 2;
  constexpr int RB = kNP * 2;
  const int wu = __builtin_amdgcn_readfirstlane(w);
  const __amdgpu_buffer_rsrc_t rw = BUF_RSRC(p.proj);
  const __amdgpu_buffer_rsrc_t rm = BUF_RSRC(p.mix + (size_t)(b * kL) * 2048 + 1024 + hd * 64);
  const int oH = (int)((const char*)p.halo - (const char*)p.proj), oD = (int)((const char*)p.dt - (const char*)p.proj), oC = (int)((const char*)p.cbb - (const char*)p.proj);
  auto xoff0 = [&](int t, int ch) -> int { return (t < 61) ? (((b * kL + t) * kNP + 5120 + ch) * 2) : (oH + ((b * 64 * 3 + (t - 61)) * 1536 + ch) * 2); };
  auto xinc = [&](int t) -> int { return (t < 61) ? 64 * RB : 9216; };
  int vC = xoff0(crow, chC + cseg); const int iC = xinc(crow);
  int vX[4], iX[4];
#pragma unroll
  for (int j = 0; j < 4; ++j) { vX[j] = xoff0(xg * 4 + j, chX + 2 * xp); iX[j] = xinc(xg * 4 + j); }
  int vO = xoff0(tt * 16 + fr, chX + pb + fq * 8); const int iO = xinc(tt * 16 + fr);
  const int vo_z = ((tt * 16 + fr) * kNP + 4096 + hd * 64 + pb + fq * 8) * 2;
  const int vo_cb = ((tt * 16 + fr) * 64 + fq * 4) * 4;
  const int vo_o = (tt * 16 + fr) * 4096 + (pb + fq * 8) * 2;
  auto load_chunk = [&](int c) {
    cC[0] = BUF_LD128(rw, vC, 0); cC[1] = BUF_LD128(rw, vC + 16, 0); vC += iC;
    { const int so = oC + ((b * 64 + c) * 2 + g) * 16384;
      cbv[0] = (st0 <= tt) ? __builtin_bit_cast(f32x4, BUF_LD128(rw, vo_cb + st0 * 64, so)) : (f32x4){0.f, 0.f, 0.f, 0.f};
      cbv[1] = (st0 + 1 <= tt) ? __builtin_bit_cast(f32x4, BUF_LD128(rw, vo_cb + (st0 + 1) * 64, so)) : (f32x4){0.f, 0.f, 0.f, 0.f}; }
#pragma unroll
    for (int j = 0; j < 8; ++j) { const int row = wu * 8 + j;
      const int so = (row < 61) ? (((b * kL + c * 64 + row) * kNP + 5120 + chB) * 2) : (oH + (((b * 64 + c) * 3 + (row - 61)) * 1536 + chB) * 2);
      tB[j] = BUF_LD(rw, cp * 4, so); }
#pragma unroll
    for (int j = 0; j < 4; ++j) { tX[j] = BUF_LD(rw, vX[j], 0); vX[j] += iX[j]; }
    dtl = __uint_as_float(BUF_LD(rw, lane * 64 + hd * 4, oD + (b * kL + c * 64) * 64));
  };
  load_chunk(0);
  const int sgu = __builtin_amdgcn_readfirstlane(w);
  float n_dt, n_cs, n_cl, n_scl;
  auto scan_next = [&]() {
    n_dt = dtl; float cs = n_dt * A;
#pragma unroll
    for (int o2 = 1; o2 < 64; o2 <<= 1) { const float up = __shfl_up(cs, o2); if (lane >= o2) cs += up; }
    n_cs = cs; n_cl = __shfl(cs, 63); n_scl = fast_exp(n_cl - cs) * n_dt;
  };
  scan_next();
  for (int c = 0; c < 64; ++c) {
    const float dtc = n_dt, cs = n_cs, cs_last = n_cl, scl = n_scl;
    const f32x4 cb0 = cbv[0], cb1 = cbv[1];
    if (w == 0) { csl[lane] = cs; dtl_s[lane] = dtc; }
    LDS_U32X4(Cc + ((crow * SQ + cseg) << 1)) = cC[0]; LDS_U32X4(Cc + ((crow * SQ + cseg + 8) << 1)) = cC[1];
    {
      u32x4v d0, d1;
#pragma unroll
      for (int i = 0; i < 4; ++i) {
        const float s0 = __int_as_float(__builtin_amdgcn_readlane(__float_as_int(scl), sgu * 8 + 2 * i)), s1 = __int_as_float(__builtin_amdgcn_readlane(__float_as_int(scl), sgu * 8 + 2 * i + 1));
        d0[i] = pk_bf16(bflo(tB[2 * i]) * s0, bflo(tB[2 * i + 1]) * s1); d1[i] = pk_bf16(bfhi(tB[2 * i]) * s0, bfhi(tB[2 * i + 1]) * s1); }
      LDS_U32X4(BdT + (((2 * cp) * SS + sg * 8) << 1)) = d0; LDS_U32X4(BdT + (((2 * cp + 1) * SS + sg * 8) << 1)) = d1;
      u32x2v x0, x1;
#pragma unroll
      for (int i = 0; i < 2; ++i) { x0[i] = (tX[2 * i] & 0xffffu) | (tX[2 * i + 1] << 16); x1[i] = (tX[2 * i] >> 16) | (tX[2 * i + 1] & 0xffff0000u); }
      LDS_U32X2(xsT + (((2 * xp) * SS + xg * 4) << 1)) = x0; LDS_U32X2(xsT + (((2 * xp + 1) * SS + xg * 4) << 1)) = x1;
    }
    const u32x4v zg = BUF_LD128(rw, vo_z, (b * kL + c * 64) * RB);
    const u32x4v xo = BUF_LD128(rw, vO, 0); vO += iO;
    if (c + 1 < 64) load_chunk(c + 1);
    __syncthreads();
#pragma unroll
    for (int i = 0; i < 4; ++i) { const int nt = (w & 1) * 4 + i;
      LDS_U32X2(stT + (((pt * 16 + fr) * SQ + nt * 16 + fq * 4) << 1)) = (u32x2v){pk_bf16(st[i][0], st[i][1]), pk_bf16(st[i][2], st[i][3])}; }
    const float cst = __shfl(cs, tt * 16 + fr);
    {
      const f32x4 a2[2] = {cb0, cb1};
      const int t = tt * 16 + fr;
#pragma unroll
      for (int i = 0; i < 2; ++i) { const int s0 = (st0 + i) * 16 + fq * 4;
        const f32x4 css = LDS_F32X4(csl + s0), dts = LDS_F32X4(dtl_s + s0);
        float wv[4];
#pragma unroll
        for (int r = 0; r < 4; ++r) wv[r] = (s0 + r <= t) ? a2[i][r] * fast_exp(cst - css[r]) * dts[r] : 0.f;
        LDS_U32X2(wl + ((t * SS + s0) << 1)) = (u32x2v){pk_bf16(wv[0], wv[1]), pk_bf16(wv[2], wv[3])}; }
    }
    {
      const float dk = fast_exp(cs_last);
#pragma unroll
      for (int i = 0; i < 4; ++i) st[i] = st[i] * dk;
#pragma unroll
      for (int ks = 0; ks < 1; ++ks) {
        bf16x8 Bf[2], Af[2][4];
#pragma unroll
        for (int k2 = 0; k2 < 2; ++k2) { Bf[k2] = lds_frag(xsT, pt * 16 + fr, k2 * 32 + fq * 8, SS);
#pragma unroll
          for (int i = 0; i < 4; ++i) Af[k2][i] = lds_frag(BdT, ((w & 1) * 4 + i) * 16 + fr, k2 * 32 + fq * 8, SS); }
        __builtin_amdgcn_sched_barrier(0);
#pragma unroll
        for (int k2 = 0; k2 < 2; ++k2)
#pragma unroll
          for (int i = 0; i < 4; ++i) st[i] = MFMA16(Af[k2][i], Bf[k2], st[i]);
      }
    }
    __syncthreads();
    __builtin_amdgcn_s_setprio(1);
    {
      f32x4 yo[2], yd[2];
#pragma unroll
      for (int i = 0; i < 2; ++i) { yo[i] = (f32x4){0.f, 0.f, 0.f, 0.f}; yd[i] = yo[i]; }
      const int prow = pb + (fr >> 2) * 8 + (fr & 3);
      {
        bf16x8 Tc[4], Ps[4][2], Tw[2], Px[2][2];
#pragma unroll
        for (int ks = 0; ks < 4; ++ks) { Tc[ks] = lds_frag(Cc, tt * 16 + fr, ks * 32 + fq * 8, SQ);
#pragma unroll
          for (int i = 0; i < 2; ++i) Ps[ks][i] = lds_frag(stT, prow + i * 4, ks * 32 + fq * 8, SQ); }
#pragma unroll
        for (int ks = 0; ks < 2; ++ks) { Tw[ks] = lds_frag(wl, tt * 16 + fr, ks * 32 + fq * 8, SS);
#pragma unroll
          for (int i = 0; i < 2; ++i) Px[ks][i] = lds_frag(xsT, prow + i * 4, ks * 32 + fq * 8, SS); }
        __builtin_amdgcn_sched_barrier(0);
#pragma unroll
        for (int ks = 0; ks < 4; ++ks)
#pragma unroll
          for (int i = 0; i < 2; ++i) yo[i] = MFMA16(Ps[ks][i], Tc[ks], yo[i]);
#pragma unroll
        for (int ks = 0; ks < 2; ++ks)
#pragma unroll
          for (int i = 0; i < 2; ++i) yd[i] = MFMA16(Px[ks][i], Tw[ks], yd[i]);
      }
      __builtin_amdgcn_s_setprio(0);
      const float ec = fast_exp(cst);
      const unsigned zw[4] = {zg.x, zg.y, zg.z, zg.w}, xw[4] = {xo.x, xo.y, xo.z, xo.w};
      u32x4v ow;
#pragma unroll
      for (int i = 0; i < 2; ++i) {
        ow[2 * i] = pk_bf16((yd[i][0] + ec * yo[i][0] + Dk * bflo(xw[2 * i])) * bflo(zw[2 * i]), (yd[i][1] + ec * yo[i][1] + Dk * bfhi(xw[2 * i])) * bfhi(zw[2 * i]));
        ow[2 * i + 1] = pk_bf16((yd[i][2] + ec * yo[i][2] + Dk * bflo(xw[2 * i + 1])) * bflo(zw[2 * i + 1]), (yd[i][3] + ec * yo[i][3] + Dk * bfhi(xw[2 * i + 1])) * bfhi(zw[2 * i + 1])); }
      BUF_ST128(ow, rm, vo_o, c * 64 * 4096);
    }
    if (c + 1 < 64) scan_next();
    __syncthreads();
  }
}

__device__ void phase_postnorm(const Params& p) {
  const int tid = opaque_tid(), lane = tid & 63, wid = tid >> 6;
  const int gw = blockIdx.x * (blockDim.x >> 6) + wid, GW = gridDim.x * (blockDim.x >> 6);
  for (int row0 = gw * 2; row0 < kT; row0 += GW * 2) {
    u32x4v raw[2][4], gg[2][2];
#pragma unroll
    for (int r = 0; r < 2; ++r) {
      const u16* mr = p.mix + (size_t)(row0 + r) * 2048 + lane * 8;
#pragma unroll
      for (int q = 0; q < 4; ++q) raw[r][q] = *(const u32x4v*)(mr + q * 512);
      const u16* gr = p.proj + (size_t)(row0 + r) * kNP + 3072 + lane * 8;
      gg[r][0] = __builtin_nontemporal_load((const u32x4v*)gr); gg[r][1] = __builtin_nontemporal_load((const u32x4v*)(gr + 512));
    }
#pragma unroll
    for (int r = 0; r < 2; ++r) {
      u16* mr = p.mix + (size_t)(row0 + r) * 2048 + lane * 8;
#pragma unroll
      for (int q = 0; q < 4; ++q) {
        float v[8]; float ss = 0.f;
#pragma unroll
        for (int i = 0; i < 4; ++i) { v[2 * i] = bflo(raw[r][q][i]); v[2 * i + 1] = bfhi(raw[r][q][i]); ss += v[2 * i] * v[2 * i] + v[2 * i + 1] * v[2 * i + 1]; }
        u32x4v ow;
        if (q < 2) {
          ss += __shfl_xor(ss, 1); ss += __shfl_xor(ss, 2); ss += __shfl_xor(ss, 4); ss += __shfl_xor(ss, 8);
          const float rs = rsqrtf(ss * (1.f / 128.f) + kEps);
          const float* nw = p.hg_nw + q * 512 + lane * 8;
#pragma unroll
          for (int i = 0; i < 4; ++i) ow[i] = hw_pk_bf16(v[2 * i] * rs * nw[2 * i] * bflo(gg[r][q][i]), v[2 * i + 1] * rs * nw[2 * i + 1] * bfhi(gg[r][q][i]));
        } else {
          ss = wave_sum(ss);
          const float rs = rsqrtf(ss * (1.f / 512.f) + kEps);
          const float* nw = p.m2_nw + (q - 2) * 512 + lane * 8;
#pragma unroll
          for (int i = 0; i < 4; ++i) ow[i] = hw_pk_bf16(v[2 * i] * rs * nw[2 * i], v[2 * i + 1] * rs * nw[2 * i + 1]);
        }
        *(u32x4v*)(mr + q * 512) = ow;
      }
    }
  }
}

__device__ void phase_final(const Params& p) {
  const int tid = opaque_tid(), lane = tid & 63, wid = tid >> 6;
  const int gw = blockIdx.x * (blockDim.x >> 6) + wid, GW = gridDim.x * (blockDim.x >> 6);
  for (int row0 = gw * 4; row0 < kT; row0 += GW * 4) {
    float4 v[4][4]; float ss[4];
#pragma unroll
    for (int r = 0; r < 4; ++r) { const float4* xr = (const float4*)(p.xres + (size_t)(row0 + r) * 1024);
#pragma unroll
      for (int i = 0; i < 4; ++i) v[r][i] = xr[i * 64 + lane]; }
#pragma unroll
    for (int r = 0; r < 4; ++r) { float a = 0.f;
#pragma unroll
      for (int i = 0; i < 4; ++i) a += v[r][i].x * v[r][i].x + v[r][i].y * v[r][i].y + v[r][i].z * v[r][i].z + v[r][i].w * v[r][i].w;
      ss[r] = wave_sum(a); }
#pragma unroll
    for (int i = 0; i < 4; ++i) { const float4 w = ((const float4*)p.fin_w)[i * 64 + lane];
#pragma unroll
      for (int r = 0; r < 4; ++r) { const float rs = rsqrtf(ss[r] * (1.f / 1024.f) + kEps);
        float4 o; o.x = v[r][i].x * rs * w.x; o.y = v[r][i].y * rs * w.y; o.z = v[r][i].z * rs * w.z; o.w = v[r][i].w * rs * w.w;
        ((float4*)(p.out + (size_t)(row0 + r) * 1024))[i * 64 + lane] = o; } }
  }
}

#define XB_TMO      128
#define XB_XCNT(j)  (256  + 64 * (j))
#define XB_XSUB(j)  (1280 + 64 * (j))
#define XB_XGEN(j)  (2304 + 64 * (j))
#define XB_TOP      3328
#define XB_TOPGEN   3392
#define XCD_BAR_WORDS 3456
#define XB_SPIN_CAP (1u << 18)
#define LAS __attribute__((address_space(3)))

__device__ __forceinline__ unsigned xb_ld(unsigned* p)              { return __hip_atomic_load(p, __ATOMIC_RELAXED, __HIP_MEMORY_SCOPE_AGENT); }
__device__ __forceinline__ unsigned xb_add(unsigned* p, unsigned v) { return __hip_atomic_fetch_add(p, v, __ATOMIC_RELAXED, __HIP_MEMORY_SCOPE_AGENT); }
__device__ __forceinline__ unsigned xb_xcc_id() { return (unsigned)__builtin_amdgcn_s_getreg((3 << 11) | 20) & 0xFu; }
#define XB_SPIN(cond, bar) do { unsigned _sp = 0; while (cond) { __builtin_amdgcn_s_sleep(1); \
    if ((++_sp & 255u) == 0u) { if (xb_ld(&(bar)[XB_TMO])) break; if (_sp > XB_SPIN_CAP) { atomicAdd(&(bar)[XB_TMO], 1u); break; } } } } while (0)

struct XcdBarrier {
    unsigned* bar; unsigned x;
    volatile LAS unsigned* st;
};

__device__ __forceinline__ XcdBarrier xcd_barrier_post(unsigned* bar, volatile LAS unsigned* st) {
    XcdBarrier b; b.bar = bar; b.x = xb_xcc_id(); b.st = st;
    if (threadIdx.x == 0) (void)xb_add(&bar[XB_XCNT(b.x)], 1u);
    return b;
}
__device__ __forceinline__ void xcd_barrier_complete(unsigned* bar, unsigned x, unsigned& nloc, unsigned& nx) {
    const unsigned G = gridDim.x * gridDim.y * gridDim.z;
    unsigned sum, cnt, mine, sp = 0u;
    for (;;) {
        sum = 0u; cnt = 0u; mine = 0u;
#pragma unroll
        for (unsigned j = 0; j < 16; ++j) { const unsigned c = xb_ld(&bar[XB_XCNT(j)]); sum += c; cnt += (c > 0u) ? 1u : 0u; mine = (j == x) ? c : mine; }
        if (sum == G) break;
        __builtin_amdgcn_s_sleep(1);
        if ((++sp & 255u) == 0u) { if (xb_ld(&bar[XB_TMO])) break; if (sp > XB_SPIN_CAP) { atomicAdd(&bar[XB_TMO], 1u); break; } }
    }
    nloc = mine > 0u ? mine : 1u; nx = cnt > 0u ? cnt : 1u;
}

__device__ __forceinline__ void xcd_barrier(const XcdBarrier& b) {
    asm volatile("s_waitcnt vmcnt(0)" ::: "memory");
    __syncthreads();
    if (threadIdx.x == 0) {
        unsigned* bar = b.bar;
        __builtin_amdgcn_s_waitcnt(0);
        unsigned nloc = b.st[0], nx = b.st[1];
        if (nloc == 0u) { xcd_barrier_complete(bar, b.x, nloc, nx); b.st[0] = nloc; b.st[1] = nx; }
        const unsigned old = xb_add(&bar[XB_XSUB(b.x)], 1u);
        const unsigned gen = old / nloc;
        if (old + 1u == (gen + 1u) * nloc) {
            __builtin_amdgcn_fence(__ATOMIC_RELEASE, "agent");
            asm volatile("s_waitcnt vmcnt(0)" ::: "memory");
            const unsigned og = xb_add(&bar[XB_TOP], 1u);
            const unsigned tg = og / nx;
            if (og + 1u == (tg + 1u) * nx) xb_add(&bar[XB_TOPGEN], 1u);
            else XB_SPIN(xb_ld(&bar[XB_TOPGEN]) == tg, bar);
            __builtin_amdgcn_fence(__ATOMIC_ACQUIRE, "agent");
            xb_add(&bar[XB_XGEN(b.x)], 1u);
            asm volatile("s_waitcnt vmcnt(0)" ::: "memory");
        } else {
            XB_SPIN(xb_ld(&bar[XB_XGEN(b.x)]) == gen, bar);
            __builtin_amdgcn_fence(__ATOMIC_ACQUIRE, "agent");
            asm volatile("s_waitcnt vmcnt(0)" ::: "memory");
        }
    }
    __syncthreads();
}


extern __shared__ __attribute__((aligned(16))) char g_smem[];
constexpr int kThreads = 512;
constexpr size_t kDynLds = 131072 + 16;
__global__ void __launch_bounds__(kThreads, 2) k_mega(Params p) {
  cg::grid_group grid = cg::this_grid();
  volatile LAS unsigned* xst = (volatile LAS unsigned*)((LDSC*)g_smem + 131072);
  if (threadIdx.x < 4) xst[threadIdx.x] = 0u;
  __syncthreads();
  const XcdBarrier xb = xcd_barrier_post(p.bar, xst);
  phase_prep(p, g_smem);
  if (p.use_cg_sync) grid.sync();
  xcd_barrier(xb);
  { Epi1F e{p.proj, p.lb}; pg8::StaticOrder S; S.init(kT, kNP, (int)gridDim.x, (int)blockIdx.x);
    pg8::gemm_phase<Epi1F, pg8::StaticOrder, false>((PG8_LAS unsigned char*)g_smem, pg8::Gemm{p.h, p.Wt1, kT, kNP, 1024}, S, e, nullptr);
    phase_dt(p); }
  xcd_barrier(xb);
  phase_premix(p);
  xcd_barrier(xb);
  phase_cb(p);
  xcd_barrier(xb);
  for (int u = blockIdx.x; u < 256; u += gridDim.x) {
    const int xcd = u & 7, slot = u >> 3;
    if (slot < 16) { const int G = xcd * 2 + (slot >> 3); mamba2_fast(p, (G >> 1) * 16 + (G & 1) * 8 + (slot & 7), (LDSC*)g_smem); }
    else { const int pair = xcd * 8 + ((slot - 16) >> 1); hgrn2_fast(p, pair * 2 + (slot & 1), (LDSC*)g_smem); }
    __syncthreads();
  }
  xcd_barrier(xb);
  phase_postnorm(p);
  xcd_barrier(xb);
  if (gridDim.x == 256) {
    Epi2N e{p.out, p.x, p.fin_w, p.rowss, p.pcnt}; pg8::StaticOrder S; S.init(kT, 1024, (int)gridDim.x, (int)blockIdx.x, 8);
    pg8::gemm_phase<Epi2N, pg8::StaticOrder, false>((PG8_LAS unsigned char*)g_smem, pg8::Gemm{p.mix, p.Wt2, kT, 1024, 2048}, S, e, nullptr);
  } else {
    { Epi2F e{p.xres, p.x}; pg8::StaticOrder S; S.init(kT, 1024, (int)gridDim.x, (int)blockIdx.x);
      pg8::gemm_phase<Epi2F, pg8::StaticOrder, false>((PG8_LAS unsigned char*)g_smem, pg8::Gemm{p.mix, p.Wt2, kT, 1024, 2048}, S, e, nullptr); }
    xcd_barrier(xb);
    phase_final(p);
  }
}

extern "C" void kernel_launch(void* const* d_in, const int* in_sizes, int n_in, void* d_out, int out_size, void* d_ws, size_t ws_size, hipStream_t stream) {
  Params p{};
  p.x = (const float*)d_in[0]; p.norm_w = (const float*)d_in[1]; p.w_in = (const float*)d_in[2]; p.lb_logits = (const float*)d_in[3];
  p.hg_nw = (const float*)d_in[4]; p.conv_w = (const float*)d_in[5]; p.conv_b = (const float*)d_in[6]; p.dt_bias = (const float*)d_in[7];
  p.a_log = (const float*)d_in[8]; p.d_skip = (const float*)d_in[9]; p.m2_nw = (const float*)d_in[10]; p.w_out = (const float*)d_in[11];
  p.fin_w = (const float*)d_in[12];
  p.out = (float*)d_out;
  char* ws = (char*)d_ws; size_t off = 0;
  auto take = [&](size_t bytes) { char* r = ws + off; off += (bytes + 255) & ~(size_t)255; return r; };
  p.proj = (u16*)take((size_t)kT * kNP * 2);
  p.xres = (float*)p.proj;
  p.Wt1 = (u16*)take((size_t)kNIN * 1024 * 2);
  p.Wt2 = (u16*)take((size_t)1024 * 2048 * 2);
  p.dt = (float*)take((size_t)kT * 16 * 4);
  p.lb = (float*)take(1024 * 4);
  p.dec = (float*)take((size_t)8 * 64 * 1024 * 4);
  p.halo = (u16*)take((size_t)8 * 64 * 3 * 1536 * 2);
  p.bar = (unsigned*)take((size_t)XCD_BAR_WORDS * 4);
  p.rowss = (float*)take((size_t)kT * 4);
  p.pcnt = (unsigned*)take(1024);
  p.cbb = (float*)take((size_t)1024 * 4096 * 4);
  p.h = (u16*)d_out;
  p.mix = (u16*)d_out;
  if (off > ws_size) { fprintf(stderr, "workspace too small: need %zu have %zu\n", off, ws_size); return; }
  static int grid_blocks = 0;
  if (!grid_blocks) {
    int dev = 0, cus = 0, per_cu = 0;
    hipGetDevice(&dev);
    hipFuncSetAttribute((const void*)k_mega, hipFuncAttributeMaxDynamicSharedMemorySize, (int)kDynLds);
    hipDeviceGetAttribute(&cus, hipDeviceAttributeMultiprocessorCount, dev);
    hipOccupancyMaxActiveBlocksPerMultiprocessor(&per_cu, k_mega, kThreads, kDynLds);
    if (per_cu > 2) per_cu = 2;
    grid_blocks = cus * per_cu;
  }
  (void)hipMemsetAsync(p.bar, 0, (size_t)XCD_BAR_WORDS * 4 + (size_t)kT * 4 + 1024, stream);
  void* args[] = {&p};
  hipError_t e = hipLaunchCooperativeKernel((void*)k_mega, dim3(grid_blocks), dim3(kThreads), args, kDynLds, stream);
  if (e != hipSuccess) fprintf(stderr, "cooperative launch failed: %s (grid %d)\n", hipGetErrorString(e), grid_blocks);
}
```

```cpp
#include <hip/hip_runtime.h>
#include <hip/hip_cooperative_groups.h>
#include <cstdio>
namespace cg = cooperative_groups;

typedef unsigned short u16;
typedef short bf16x8 __attribute__((ext_vector_type(8)));
typedef float f32x4 __attribute__((ext_vector_type(4)));

constexpr int kT = 32768, kL = 4096;
constexpr int kNP = 6656;
constexpr int kNIN = 6672;
constexpr float kEps = 1e-6f;

typedef __bf16 bf16x2_t __attribute__((ext_vector_type(2)));
typedef float f32x2_t __attribute__((ext_vector_type(2)));
__device__ __forceinline__ unsigned hw_pk_bf16(float lo, float hi) { const f32x2_t v = {lo, hi}; return __builtin_bit_cast(unsigned, __builtin_convertvector(v, bf16x2_t)); }
__device__ __forceinline__ u16 f2bf(float f) { return (u16)(hw_pk_bf16(f, 0.f) & 0xffffu); }
__device__ __forceinline__ float bf2f(u16 b) { return __uint_as_float(((unsigned)b) << 16); }
__device__ __forceinline__ u16 f2h(float f) { _Float16 h = (_Float16)f; return __builtin_bit_cast(u16, h); }
__device__ __forceinline__ float h2f(u16 b) { return (float)__builtin_bit_cast(_Float16, b); }
__device__ __forceinline__ float fast_exp(float x) { return __builtin_amdgcn_exp2f(x * 1.44269504088896f); }
__device__ __forceinline__ float fast_log(float x) { return __builtin_amdgcn_logf(x) * 0.693147180559945f; }
__device__ __forceinline__ float siluf(float v) { return v * __builtin_amdgcn_rcpf(1.f + fast_exp(-v)); }
__device__ __forceinline__ float sigmf(float v) { return __builtin_amdgcn_rcpf(1.f + fast_exp(-v)); }
__device__ __forceinline__ float wave_sum(float v) {
#pragma unroll
  for (int o = 32; o >= 1; o >>= 1) v += __shfl_xor(v, o);
  return v;
}

__device__ __forceinline__ int opaque_tid() { int t = threadIdx.x; asm volatile("" : "+v"(t)); return t; }

struct Params {
  const float* x; const float* norm_w; const float* w_in; const float* lb_logits; const float* hg_nw;
  const float* conv_w; const float* conv_b; const float* dt_bias; const float* a_log; const float* d_skip;
  const float* m2_nw; const float* w_out; const float* fin_w;
  float* out;
  u16* h; u16* Wt1; u16* Wt2; u16* proj; float* dt; u16* mix; float* lb; float* xres; float* dec; u16* halo; unsigned* bar; float* rowss; unsigned* pcnt; float* cbb; int use_cg_sync; int pad0;
};

__device__ void transpose_cvt(const float* src, int K, int N, u16* dst, float* tile  ) {
  const int tid = opaque_tid();
  const int nk = K / 128, nn = (N + 63) / 64;
  for (int t = blockIdx.x; t < nk * nn; t += gridDim.x) {
    const int tk = t % nk, tn = t / nk;
    float v[16];
#pragma unroll
    for (int e = 0; e < 16; ++e) { const int idx = e * 512 + tid, r = idx >> 6, c = idx & 63; const int n = tn * 64 + c;
      v[e] = (n < N) ? __builtin_nontemporal_load(src + (size_t)(tk * 128 + r) * N + n) : 0.f; }
#pragma unroll
    for (int e = 0; e < 16; ++e) { const int idx = e * 512 + tid, r = idx >> 6, c = idx & 63; tile[r * 65 + c] = v[e]; }
    __syncthreads();
#pragma unroll
    for (int e = 0; e < 8; ++e) { const int idx = e * 512 + tid, nr = idx >> 6, kp = idx & 63; const int n = tn * 64 + nr;
      if (n < N) *(unsigned*)(dst + (size_t)n * K + tk * 128 + 2 * kp) = hw_pk_bf16(tile[(2 * kp) * 65 + nr], tile[(2 * kp + 1) * 65 + nr]); }
    __syncthreads();
  }
}

__device__ void phase_prep(const Params& p, char* smem) {
  const int tid = opaque_tid(), lane = tid & 63, wid = tid >> 6;
  const int gt = blockIdx.x * blockDim.x + tid;
  if (gt < 1024) { const float l0 = p.lb_logits[gt], l1 = p.lb_logits[1024 + gt]; p.lb[gt] = 1.f / (1.f + expf(l1 - l0)); }
  transpose_cvt(p.w_in, 1024, kNIN, p.Wt1, (float*)smem);
  transpose_cvt(p.w_out, 2048, 1024, p.Wt2, (float*)smem);
  const int gw = blockIdx.x * (blockDim.x >> 6) + wid, GW = gridDim.x * (blockDim.x >> 6);
  for (int row0 = gw * 4; row0 < kT; row0 += GW * 4) {
    float4 v[4][4]; float ss[4];
#pragma unroll
    for (int r = 0; r < 4; ++r) { const f32x4* xr = (const f32x4*)(p.x + (size_t)(row0 + r) * 1024);
#pragma unroll
      for (int i = 0; i < 4; ++i) { const f32x4 t4 = __builtin_nontemporal_load(xr + i * 64 + lane); v[r][i] = make_float4(t4[0], t4[1], t4[2], t4[3]); } }
#pragma unroll
    for (int r = 0; r < 4; ++r) { float a = 0.f;
#pragma unroll
      for (int i = 0; i < 4; ++i) a += v[r][i].x * v[r][i].x + v[r][i].y * v[r][i].y + v[r][i].z * v[r][i].z + v[r][i].w * v[r][i].w;
      ss[r] = wave_sum(a); }
#pragma unroll
    for (int i = 0; i < 4; ++i) { const float4 w = ((const float4*)p.norm_w)[i * 64 + lane];
#pragma unroll
      for (int r = 0; r < 4; ++r) { const float rs = rsqrtf(ss[r] * (1.f / 1024.f) + kEps);
        uint2 o; o.x = hw_pk_bf16(v[r][i].x * rs * w.x, v[r][i].y * rs * w.y); o.y = hw_pk_bf16(v[r][i].z * rs * w.z, v[r][i].w * rs * w.w);
        *(uint2*)(p.h + (size_t)(row0 + r) * 1024 + (i * 64 + lane) * 4) = o; } }
  }
}

namespace pg8 {
#define PG8_LAS __attribute__((address_space(3)))
typedef unsigned short bf16_t;
typedef short bf16x8 __attribute__((ext_vector_type(8)));
typedef float f32x4 __attribute__((ext_vector_type(4)));
typedef unsigned u32x4 __attribute__((ext_vector_type(4)));
constexpr int BM = 256, BK = 64, HALF = 128, HTB = HALF * BK * 2  , STAGE_BYTES = 8 * HTB, NXCD = 8, WGM = 4;

__host__ __device__ __forceinline__ int lds_byte(int r, int c) { const int st = (r >> 4) * 2 + (c >> 5), rr = r & 15, cc = c & 31, ob = rr * 64 + cc * 2; return st * 1024 + (ob ^ (((ob >> 9) & 1) << 5)); }
__host__ __device__ __forceinline__ void stage_rc(int b, int& R, int& C) { const int st = b / 1024, sb = b % 1024, swz = sb ^ (((sb >> 9) & 1) << 5); R = (st >> 1) * 16 + swz / 64; C = (st & 1) * 32 + (swz % 64) / 2; }
__host__ __device__ __forceinline__ int perm32(int rho) { const int n = rho >> 4, i = rho & 15; return 8 * (i >> 2) + 4 * n + (i & 3); }

struct Unit { int pm, pn; };
struct Gemm { const bf16_t* A; const bf16_t* Bt; int M, N, K; };

struct StaticOrder {
    int nM, nN, nwg, G, c;
    __host__ __device__ void init(int M, int N, int G_, int c_) { nM = M / BM; nN = N / BM; nwg = nM * nN; G = G_; c = c_; }
    __host__ __device__ bool next(int i, Unit& u) const {
        const long L = (long)i * G + c; if (L >= nwg) return false;
        int wgid = (int)L; { const int q = nwg / NXCD, r = nwg % NXCD, xcd = wgid % NXCD, off = wgid / NXCD; wgid = (xcd < r ? xcd * (q + 1) : r * (q + 1) + (xcd - r) * q) + off; }
        const int nig = WGM * nN, gid = wgid / nig, fm = gid * WGM, gsz = (nM - fm) < WGM ? (nM - fm) : WGM;
        u.pm = fm + ((wgid % nig) % gsz); u.pn = (wgid % nig) / gsz; return true;
    }
    __device__ __forceinline__ void a_ready(const Unit&) const {}
    __device__ __forceinline__ void done(const Unit&) const {}
};
__device__ __forceinline__ unsigned cvt_pk_bf16(float lo, float hi) { return hw_pk_bf16(lo, hi); }
template <class Epi, class Sched, bool STAMP = false>
__device__ __forceinline__ void gemm_phase(PG8_LAS unsigned char* lds, const Gemm g, const Sched& S, const Epi& E, unsigned long long* stamps) {
    const int tid = opaque_tid(), wid = __builtin_amdgcn_readfirstlane(tid >> 6), lane = tid & 63, wr = wid >> 2, wc = wid & 3, fr = lane & 15, fq = lane >> 4;
    const int K = g.K, nt = K / BK;
    int ts_lo = 0, ts_hi = 0, nts = 0; const unsigned long long rt_entry = STAMP ? (unsigned long long)wall_clock64() : 0ull;
#define PG8_STAMP() do { if (STAMP && wid == 0 && nts < 64) { const unsigned long long _c = (unsigned long long)clock64(); \
        ts_lo = (lane == nts) ? (int)(unsigned)_c : ts_lo; ts_hi = (lane == nts) ? (int)(unsigned)(_c >> 32) : ts_hi; ++nts; } } while (0)
    PG8_STAMP();
    unsigned voffA[2], voffB[2];
#pragma unroll
    for (int i = 0; i < 2; ++i) { int R, C; stage_rc(tid * 16 + i * 8192, R, C); const int Rb = Epi::PERM ? ((R & ~31) + perm32(R & 31)) : R;
        voffA[i] = (unsigned)(R * K + C) * 2u; voffB[i] = (unsigned)(Rb * K + C) * 2u; }
    const size_t kstep = (size_t)(BK * 2);
    const size_t hstep = (size_t)HALF * K * 2;
    const size_t tstep = 2 * hstep;
    const unsigned ldsw = (unsigned)wid * 1024u;
    const int aoff = lds_byte(wr * 64 + fr, fq * 8), boff = lds_byte(wc * 32 + fr, fq * 8);
#define PG8_SA(b, h) (((b) * 2 + (h)) * HTB)
#define PG8_SB(b, h) ((4 + (b) * 2 + (h)) * HTB)
#define PG8_STAGE(bufoff, gbase, voff) do { _Pragma("unroll") for (int _i = 0; _i < 2; ++_i) \
        __builtin_amdgcn_global_load_lds((const unsigned*)((const char*)(gbase) + (voff)[_i]), (PG8_LAS unsigned*)(lds + (bufoff) + ldsw + _i * 8192), 16, 0, 0); } while (0)
#define PG8_LDA(dst, b, h) do { _Pragma("unroll") for (int m = 0; m < 4; ++m) _Pragma("unroll") for (int k = 0; k < 2; ++k) dst[m][k] = *(const PG8_LAS bf16x8*)(lds + PG8_SA(b, h) + aoff + m * 2048 + k * 1024); } while (0)
#define PG8_LDB(dst, b, h) do { _Pragma("unroll") for (int n = 0; n < 2; ++n) _Pragma("unroll") for (int k = 0; k < 2; ++k) dst[n][k] = *(const PG8_LAS bf16x8*)(lds + PG8_SB(b, h) + boff + n * 2048 + k * 1024); } while (0)
#define PG8_MMA(ai, bj, At, Bt) do { __builtin_amdgcn_s_setprio(1); _Pragma("unroll") for (int m = 0; m < 4; ++m) _Pragma("unroll") for (int n = 0; n < 2; ++n) _Pragma("unroll") for (int k = 0; k < 2; ++k) \
        acc[ai][bj][m][n] = __builtin_amdgcn_mfma_f32_16x16x32_bf16(Bt[n][k], At[m][k], acc[ai][bj][m][n], 0, 0, 0); __builtin_amdgcn_s_setprio(0); } while (0)
#define PG8_WAIT_V(n) asm volatile("s_waitcnt vmcnt(" #n ")" ::: "memory")
#define PG8_WAIT_L(n) asm volatile("s_waitcnt lgkmcnt(" #n ")" ::: "memory")
#define PG8_BAR __builtin_amdgcn_s_barrier()
#define PG8_SCHED __builtin_amdgcn_sched_barrier(0)
    Unit cur, nxt; int ui = 0;
    if (!S.next(0, cur)) return;
    f32x4 acc[2][2][4][2];
#pragma unroll
    for (int a = 0; a < 2; ++a)
#pragma unroll
        for (int b = 0; b < 2; ++b)
#pragma unroll
            for (int m = 0; m < 4; ++m)
#pragma unroll
                for (int n = 0; n < 2; ++n) acc[a][b][m][n] = (f32x4){0.f, 0.f, 0.f, 0.f};
    bf16x8 At[4][2], B0[2][2], B1[2][2];
    const char* cA = (const char*)g.A + (size_t)cur.pm * tstep; const char* cB = (const char*)g.Bt + (size_t)cur.pn * tstep;
    S.a_ready(cur);
    PG8_STAGE(PG8_SB(0, 0), cB, voffB); PG8_STAGE(PG8_SA(0, 0), cA, voffA); PG8_STAGE(PG8_SB(0, 1), cB + hstep, voffB); PG8_STAGE(PG8_SA(0, 1), cA + hstep, voffA);
    if (wr == 1) PG8_BAR;
    PG8_WAIT_V(4); PG8_BAR;
    PG8_STAGE(PG8_SB(1, 0), cB + kstep, voffB); PG8_STAGE(PG8_SA(1, 0), cA + kstep, voffA); PG8_STAGE(PG8_SB(1, 1), cB + hstep + kstep, voffB);
    PG8_WAIT_V(6); PG8_BAR;
    PG8_STAMP();
    for (;;) {
        const bool has_next = S.next(ui + 1, nxt);
        const char* nA = has_next ? (const char*)g.A + (size_t)nxt.pm * tstep : cA; const char* nB = has_next ? (const char*)g.Bt + (size_t)nxt.pn * tstep : cB;
        for (int t = 0; t < nt; t += 2) {
            const bool last = (t == nt - 2);
            const char* a1 = cA + (size_t)(t + 1) * kstep;
            const char* a2 = last ? nA : cA + (size_t)(t + 2) * kstep; const char* b2 = last ? nB : cB + (size_t)(t + 2) * kstep;
            const char* a3 = a2 + kstep; const char* b3 = b2 + kstep;
            if (last && has_next) S.a_ready(nxt);
            PG8_LDB(B0, 0, 0); PG8_SCHED; PG8_LDA(At, 0, 0); PG8_STAGE(PG8_SA(1, 1), a1 + hstep, voffA);
            PG8_WAIT_L(8); PG8_BAR; PG8_WAIT_L(0); PG8_MMA(0, 0, At, B0); PG8_BAR; PG8_SCHED;
            PG8_LDB(B1, 0, 1); PG8_STAGE(PG8_SB(0, 0), b2, voffB);
            PG8_BAR; PG8_WAIT_L(0); PG8_MMA(0, 1, At, B1); PG8_BAR;
            PG8_LDA(At, 0, 1); PG8_STAGE(PG8_SA(0, 0), a2, voffA);
            PG8_BAR; PG8_WAIT_L(0); PG8_MMA(1, 0, At, B0); PG8_BAR; PG8_SCHED;
            PG8_STAGE(PG8_SB(0, 1), b2 + hstep, voffB);
            PG8_WAIT_V(6); PG8_BAR; PG8_MMA(1, 1, At, B1); PG8_BAR;
            PG8_LDB(B0, 1, 0); PG8_SCHED; PG8_LDA(At, 1, 0); PG8_STAGE(PG8_SA(0, 1), a2 + hstep, voffA);
            PG8_WAIT_L(8); PG8_BAR; PG8_WAIT_L(0); PG8_MMA(0, 0, At, B0); PG8_BAR; PG8_SCHED;
            PG8_LDB(B1, 1, 1); PG8_STAGE(PG8_SB(1, 0), b3, voffB);
            PG8_BAR; PG8_WAIT_L(0); PG8_MMA(0, 1, At, B1); PG8_BAR;
            PG8_LDA(At, 1, 1); PG8_STAGE(PG8_SA(1, 0), a3, voffA);
            PG8_BAR; PG8_WAIT_L(0); PG8_MMA(1, 0, At, B0); PG8_BAR; PG8_SCHED;
            PG8_STAGE(PG8_SB(1, 1), b3 + hstep, voffB);
            PG8_WAIT_V(6); PG8_BAR; PG8_MMA(1, 1, At, B1); PG8_BAR;
        }
        PG8_STAMP();
        if constexpr (!Epi::AFTER_DRAIN) { E(acc, cur, wr, wc, fr, fq); S.done(cur); }
        PG8_STAMP();
        if (!has_next) break;
#pragma unroll
        for (int a = 0; a < 2; ++a)
#pragma unroll
            for (int b = 0; b < 2; ++b)
#pragma unroll
                for (int m = 0; m < 4; ++m)
#pragma unroll
                    for (int n = 0; n < 2; ++n) acc[a][b][m][n] = (f32x4){0.f, 0.f, 0.f, 0.f};
        cur = nxt; cA = nA; cB = nB; ++ui;
    }
    PG8_WAIT_V(0);
    if (wr == 0) PG8_BAR;
    PG8_BAR;
    if constexpr (Epi::AFTER_DRAIN) { E.fused(acc, cur, wr, wc, fr, fq, lds, wid, lane); S.done(cur); }
    PG8_STAMP();
    if (STAMP && wid == 0) { stamps[lane] = lane < nts ? (((unsigned long long)(unsigned)ts_hi << 32) | (unsigned)ts_lo) : 0ull;
        if (lane == 62) stamps[62] = rt_entry; if (lane == 63) stamps[63] = (unsigned long long)wall_clock64(); }
#undef PG8_STAMP
#undef PG8_SA
#undef PG8_SB
#undef PG8_STAGE
#undef PG8_LDA
#undef PG8_LDB
#undef PG8_MMA
#undef PG8_WAIT_V
#undef PG8_WAIT_L
#undef PG8_BAR
#undef PG8_SCHED
}
}

struct Epi1F {
  static constexpr bool PERM = true, AFTER_DRAIN = false;
  u16* proj; const float* lb;
  __device__ __forceinline__ void operator()(const f32x4 (&acc)[2][2][4][2], const pg8::Unit& u, int wr, int wc, int fr, int fq) const {
    const int row0 = u.pm * 256 + wr * 64 + fr, col0 = u.pn * 256 + wc * 32 + 8 * fq;
    const int kind = (u.pn * 256) >> 10;
    f32x4 lbv[2][2];
#pragma unroll
    for (int bj = 0; bj < 2; ++bj)
#pragma unroll
      for (int n = 0; n < 2; ++n) lbv[bj][n] = (kind == 1) ? *(const f32x4*)(lb + (col0 - 1024) + bj * 128 + 4 * n) : (f32x4){0.f, 0.f, 0.f, 0.f};
#pragma unroll
    for (int ai = 0; ai < 2; ++ai)
#pragma unroll
      for (int m = 0; m < 4; ++m) { u16* rowp = proj + (size_t)(row0 + ai * 128 + m * 16) * kNP + col0;
#pragma unroll
        for (int bj = 0; bj < 2; ++bj) { f32x4 v0 = acc[ai][bj][m][0], v1 = acc[ai][bj][m][1];
          pg8::u32x4 w;
          if (kind == 1) {
            unsigned hw[8];
#pragma unroll
            for (int j = 0; j < 4; ++j) { const float l0 = lbv[bj][0][j], l1 = lbv[bj][1][j];
              hw[j] = f2h(fast_log(l0 + (1.f - l0) * sigmf(v0[j]))); hw[4 + j] = f2h(fast_log(l1 + (1.f - l1) * sigmf(v1[j]))); }
            w.x = hw[0] | (hw[1] << 16); w.y = hw[2] | (hw[3] << 16); w.z = hw[4] | (hw[5] << 16); w.w = hw[6] | (hw[7] << 16);
          } else {
            if (kind == 0 || kind == 3 || kind == 4) {
#pragma unroll
              for (int j = 0; j < 4; ++j) { v0[j] = siluf(v0[j]); v1[j] = siluf(v1[j]); } }
            w.x = pg8::cvt_pk_bf16(v0[0], v0[1]); w.y = pg8::cvt_pk_bf16(v0[2], v0[3]); w.z = pg8::cvt_pk_bf16(v1[0], v1[1]); w.w = pg8::cvt_pk_bf16(v1[2], v1[3]);
          }
          __builtin_nontemporal_store(w, (pg8::u32x4*)(rowp + bj * 128)); } }
  }
};
struct Epi2F {
  static constexpr bool PERM = false, AFTER_DRAIN = false;
  float* xres; const float* x;
  __device__ __forceinline__ void operator()(const f32x4 (&acc)[2][2][4][2], const pg8::Unit& u, int wr, int wc, int fr, int fq) const {
    const int row0 = u.pm * 256 + wr * 64 + fr, col0 = u.pn * 256 + wc * 32 + 4 * fq;
#pragma unroll
    for (int ai = 0; ai < 2; ++ai)
#pragma unroll
      for (int m = 0; m < 4; ++m) { const size_t ro = (size_t)(row0 + ai * 128 + m * 16) * 1024 + col0;
#pragma unroll
        for (int bj = 0; bj < 2; ++bj)
#pragma unroll
          for (int n = 0; n < 2; ++n) { const size_t o = ro + bj * 128 + n * 16; const f32x4 xv = *(const f32x4*)(x + o); *(f32x4*)(xres + o) = acc[ai][bj][m][n] + xv; } }
  }
};

struct Epi2N {
  static constexpr bool PERM = false, AFTER_DRAIN = false;
  float* out; const float* x; const float* fw; float* rowss; unsigned* pcnt;
  __device__ __forceinline__ void operator()(const f32x4 (&acc_c)[2][2][4][2], const pg8::Unit& u, int wr, int wc, int fr, int fq) const {
    f32x4 (&acc)[2][2][4][2] = const_cast<f32x4 (&)[2][2][4][2]>(acc_c);
    const int row0 = u.pm * 256 + wr * 64 + fr, col0 = u.pn * 256 + wc * 32 + 4 * fq;
    float ps[8];
#pragma unroll
    for (int ai = 0; ai < 2; ++ai)
#pragma unroll
      for (int m = 0; m < 4; ++m) { const size_t ro = (size_t)(row0 + ai * 128 + m * 16) * 1024 + col0; float sq = 0.f;
#pragma unroll
        for (int bj = 0; bj < 2; ++bj)
#pragma unroll
          for (int n = 0; n < 2; ++n) { const f32x4 xv = __builtin_nontemporal_load((const f32x4*)(x + ro + bj * 128 + n * 16)); const f32x4 v = acc[ai][bj][m][n] + xv; acc[ai][bj][m][n] = v;
            sq += v[0] * v[0] + v[1] * v[1] + v[2] * v[2] + v[3] * v[3]; }
        sq += __shfl_xor(sq, 16); sq += __shfl_xor(sq, 32); ps[ai * 4 + m] = sq; }
#pragma unroll
    for (int k = 0; k < 8; ++k)
      if ((k >> 1) == fq) (void)__hip_atomic_fetch_add(rowss + row0 + (k >> 2) * 128 + (k & 3) * 16, ps[k], __ATOMIC_RELAXED, __HIP_MEMORY_SCOPE_AGENT);
    asm volatile("s_waitcnt vmcnt(0)" ::: "memory");
    unsigned* cnt = pcnt + u.pm * 2 + wr;
    if (fr == 0 && fq == 0) (void)__hip_atomic_fetch_add(cnt, 1u, __ATOMIC_RELAXED, __HIP_MEMORY_SCOPE_AGENT);
    { unsigned spins = 0;
      while (__hip_atomic_load(cnt, __ATOMIC_RELAXED, __HIP_MEMORY_SCOPE_AGENT) < 16u && ++spins < (1u << 22)) __builtin_amdgcn_s_sleep(1); }
    float rs[8];
#pragma unroll
    for (int k = 0; k < 8; ++k) rs[k] = rsqrtf(__hip_atomic_load(rowss + row0 + (k >> 2) * 128 + (k & 3) * 16, __ATOMIC_RELAXED, __HIP_MEMORY_SCOPE_AGENT) * (1.f / 1024.f) + kEps);
    f32x4 wv[2][2];
#pragma unroll
    for (int bj = 0; bj < 2; ++bj)
#pragma unroll
      for (int n = 0; n < 2; ++n) wv[bj][n] = *(const f32x4*)(fw + col0 + bj * 128 + n * 16);
#pragma unroll
    for (int ai = 0; ai < 2; ++ai)
#pragma unroll
      for (int m = 0; m < 4; ++m) { const size_t ro = (size_t)(row0 + ai * 128 + m * 16) * 1024 + col0; const float r = rs[ai * 4 + m];
#pragma unroll
        for (int bj = 0; bj < 2; ++bj)
#pragma unroll
          for (int n = 0; n < 2; ++n) __builtin_nontemporal_store(acc[ai][bj][m][n] * r * wv[bj][n], (f32x4*)(out + ro + bj * 128 + n * 16)); }
  }
};

__device__ __forceinline__ u16 xform1(int c, float v, const float* lb) {
  if (c < 1024) return f2bf(siluf(v));
  if (c < 2048) { const float l = lb[c - 1024]; const float f = l + (1.f - l) * sigmf(v); return f2h(logf(f)); }
  if (c < 3072) return f2bf(v);
  if (c < 5120) return f2bf(siluf(v));
  return f2bf(v);
}
struct Epi1 { u16* proj; const float* lb;
  __device__ __forceinline__ void operator()(int r, int c, float v) const { proj[(size_t)r * kNP + c] = xform1(c, v, lb); } };
struct Epi2 { float* xres; const float* x;
  __device__ __forceinline__ void operator()(int r, int c, float v) const { xres[(size_t)r * 1024 + c] = x[(size_t)r * 1024 + c] + v; } };

template <class Epi>
__device__ void gemm_naive(const u16* A, const u16* Bt, int M, int N, int K, const Epi& epi) {
  const int tid = opaque_tid(), lane = tid & 63, wid = tid >> 6, fr = lane & 15, fq = lane >> 4;
  const int gw = blockIdx.x * (blockDim.x >> 6) + wid, GW = gridDim.x * (blockDim.x >> 6);
  const int nN = N / 32, ntile = (M / 32) * nN;
  for (int t = gw; t < ntile; t += GW) {
    const int m0 = (t / nN) * 32, n0 = (t % nN) * 32;
    f32x4 acc[2][2];
#pragma unroll
    for (int i = 0; i < 2; ++i)
#pragma unroll
      for (int j = 0; j < 2; ++j) acc[i][j] = (f32x4){0.f, 0.f, 0.f, 0.f};
    for (int k0 = 0; k0 < K; k0 += 32) {
      bf16x8 a[2], b[2];
#pragma unroll
      for (int i = 0; i < 2; ++i) a[i] = *(const bf16x8*)(A + (size_t)(m0 + i * 16 + fr) * K + k0 + fq * 8);
#pragma unroll
      for (int j = 0; j < 2; ++j) b[j] = *(const bf16x8*)(Bt + (size_t)(n0 + j * 16 + fr) * K + k0 + fq * 8);
#pragma unroll
      for (int i = 0; i < 2; ++i)
#pragma unroll
        for (int j = 0; j < 2; ++j) acc[i][j] = __builtin_amdgcn_mfma_f32_16x16x32_bf16(a[i], b[j], acc[i][j], 0, 0, 0);
    }
#pragma unroll
    for (int i = 0; i < 2; ++i)
#pragma unroll
      for (int j = 0; j < 2; ++j)
#pragma unroll
        for (int r = 0; r < 4; ++r) epi(m0 + i * 16 + fq * 4 + r, n0 + j * 16 + fr, acc[i][j][r]);
  }
}

__device__ void phase_dt(const Params& p) {
  const int tid = opaque_tid(), lane = tid & 63, wid = tid >> 6, fr = lane & 15, fq = lane >> 4;
  const int gw = blockIdx.x * (blockDim.x >> 6) + wid, GW = gridDim.x * (blockDim.x >> 6);
  for (int t = gw; t < kT / 16; t += GW) {
    const int m0 = t * 16;
    f32x4 acc = (f32x4){0.f, 0.f, 0.f, 0.f};
    for (int k0 = 0; k0 < 1024; k0 += 32) {
      const bf16x8 a = *(const bf16x8*)(p.h + (size_t)(m0 + fr) * 1024 + k0 + fq * 8);
      const bf16x8 b = *(const bf16x8*)(p.Wt1 + (size_t)(kNP + fr) * 1024 + k0 + fq * 8);
      acc = __builtin_amdgcn_mfma_f32_16x16x32_bf16(a, b, acc, 0, 0, 0);
    }
    const float bias = p.dt_bias[fr];
#pragma unroll
    for (int r = 0; r < 4; ++r) { const float v = acc[r] + bias; const float sp = v > 20.f ? v : log1pf(expf(v));
      p.dt[(size_t)(m0 + fq * 4 + r) * 16 + fr] = sp; }
  }
}

__device__ void hgrn2_naive(const Params& p, int unit, char* smem) {
  const int b = unit >> 3, hh = unit & 7;
  const int tid = opaque_tid(), v = tid & 127, kq = tid >> 7;
  float S[32];
#pragma unroll
  for (int i = 0; i < 32; ++i) S[i] = 0.f;
  float* sq = (float*)smem; float* sf = sq + 2048; float* sk = sf + 2048; float* sv = sk + 2048; float* sp = sv + 2048;
  for (int t0 = 0; t0 < kL; t0 += 16) {
    for (int i = tid; i < 2048; i += 512) { const int tt = i >> 7, c = i & 127; const size_t row = (size_t)(b * kL + t0 + tt) * kNP;
      sq[i] = bf2f(p.proj[row + hh * 128 + c]);
      const float f = fast_exp(h2f(p.proj[row + 1024 + hh * 128 + c])); sf[i] = f; sk[i] = 1.f - f;
      sv[i] = bf2f(p.proj[row + 2048 + hh * 128 + c]); }
    __syncthreads();
    for (int tt = 0; tt < 16; ++tt) { const float vv = sv[tt * 128 + v]; float acc = 0.f;
#pragma unroll
      for (int i = 0; i < 32; ++i) { const int k = kq * 32 + i; S[i] = sf[tt * 128 + k] * S[i] + sk[tt * 128 + k] * vv; acc += S[i] * sq[tt * 128 + k]; }
      sp[(kq * 16 + tt) * 128 + v] = acc; }
    __syncthreads();
    { const int tt = tid >> 5, l32 = tid & 31; float o[4]; float ss = 0.f;
#pragma unroll
      for (int j = 0; j < 4; ++j) { const int vv = l32 + 32 * j; o[j] = sp[(0 * 16 + tt) * 128 + vv] + sp[(1 * 16 + tt) * 128 + vv] + sp[(2 * 16 + tt) * 128 + vv] + sp[(3 * 16 + tt) * 128 + vv]; ss += o[j] * o[j]; }
#pragma unroll
      for (int off = 16; off >= 1; off >>= 1) ss += __shfl_xor(ss, off);
      const float rs = rsqrtf(ss * (1.f / 128.f) + kEps);
      const size_t row = (size_t)(b * kL + t0 + tt);
#pragma unroll
      for (int j = 0; j < 4; ++j) { const int vv = l32 + 32 * j; const float g = bf2f(p.proj[row * kNP + 3072 + hh * 128 + vv]);
        p.mix[row * 2048 + hh * 128 + vv] = f2bf(o[j] * rs * p.hg_nw[hh * 128 + vv] * g); } }
  }
}

__device__ void mamba2_naive(const Params& p, int unit, char* smem) {
  const int b = unit >> 4, hd = unit & 15, g = hd >> 3;
  const int tid = opaque_tid(), pp = tid & 63, nq = tid >> 6;
  float st[16];
#pragma unroll
  for (int i = 0; i < 16; ++i) st[i] = 0.f;
  const float A = -fast_exp(p.a_log[hd]), Dk = p.d_skip[hd];
  float* sx = (float*)smem; float* sB = sx + 16 * 64; float* sC = sB + 16 * 128; float* sdt = sC + 16 * 128; float* sp = sdt + 16;
  for (int t0 = 0; t0 < kL; t0 += 16) {
    for (int i = tid; i < 5120; i += 512) { const int tt = i / 320, c = i % 320;
      const int ch = c < 64 ? hd * 64 + c : (c < 192 ? 1024 + g * 128 + (c - 64) : 1280 + g * 128 + (c - 192));
      float acc = p.conv_b[ch];
#pragma unroll
      for (int j = 0; j < 4; ++j) { const int ts = t0 + tt - 3 + j; if (ts >= 0) acc += p.conv_w[j * 1536 + ch] * bf2f(p.proj[(size_t)(b * kL + ts) * kNP + 5120 + ch]); }
      acc = siluf(acc);
      if (c < 64) sx[tt * 64 + c] = acc; else if (c < 192) sB[tt * 128 + c - 64] = acc; else sC[tt * 128 + c - 192] = acc; }
    if (tid < 16) sdt[tid] = p.dt[(size_t)(b * kL + t0 + tid) * 16 + hd];
    __syncthreads();
    for (int tt = 0; tt < 16; ++tt) { const float dt = sdt[tt], dA = fast_exp(dt * A), dx = dt * sx[tt * 64 + pp]; float acc = 0.f;
#pragma unroll
      for (int i = 0; i < 16; ++i) { const int n = nq * 16 + i; st[i] = dA * st[i] + dx * sB[tt * 128 + n]; acc += st[i] * sC[tt * 128 + n]; }
      sp[(nq * 16 + tt) * 64 + pp] = acc; }
    __syncthreads();
    for (int i = tid; i < 1024; i += 512) { const int tt = i >> 6, q = i & 63; float y = Dk * sx[tt * 64 + q];
#pragma unroll
      for (int r = 0; r < 8; ++r) y += sp[(r * 16 + tt) * 64 + q];
      const size_t row = (size_t)(b * kL + t0 + tt); const float z = bf2f(p.proj[row * kNP + 4096 + hd * 64 + q]);
      p.mix[row * 2048 + 1024 + hd * 64 + q] = f2bf(y * z); }
    __syncthreads();
  }
}

#define BUF_RSRC(ptr) __builtin_amdgcn_make_buffer_rsrc((void*)(ptr), 0, 0x7fffffff, 0x00020000)
#define BUF_LD(rs, voff, soff) ((unsigned)__builtin_amdgcn_raw_buffer_load_b32((rs), (int)(voff), (int)(soff), 0))
#define BUF_ST(val, rs, voff, soff) __builtin_amdgcn_raw_buffer_store_b32((unsigned)(val), (rs), (int)(voff), (int)(soff), 0)
__device__ void phase_premix(const Params& p) {
  const int tid = opaque_tid(), lane = tid & 63, wid = __builtin_amdgcn_readfirstlane(tid >> 6);
  const int gw = blockIdx.x * (blockDim.x >> 6) + wid, GW = gridDim.x * (blockDim.x >> 6);
  const int loff = lane * 4;
  constexpr int RB = kNP * 2;
  for (int it = gw; it < 4096 + 6144; it += GW) {
    if (it < 4096) {
      const int hh = it & 7, bc = it >> 3;
      const __amdgpu_buffer_rsrc_t rq = BUF_RSRC(p.proj + (size_t)(bc * 64) * kNP + hh * 128);
      unsigned lf[64];
#pragma unroll
      for (int t = 0; t < 64; ++t) lf[t] = BUF_LD(rq, loff, t * RB + 2048);
      float t0 = 0.f, t1 = 0.f;
#pragma unroll
      for (int t = 0; t < 64; ++t) { t0 += h2f((u16)(lf[t] & 0xffffu)); t1 += h2f((u16)(lf[t] >> 16)); }
      float2 dv; dv.x = fast_exp(t0); dv.y = fast_exp(t1);
      *(float2*)(p.dec + (size_t)bc * 1024 + hh * 128 + 2 * lane) = dv;
      float c0 = 0.f, c1 = 0.f;
#pragma unroll
      for (int blk = 0; blk < 4; ++blk) {
        unsigned lq[16];
#pragma unroll
        for (int t = 0; t < 16; ++t) lq[t] = BUF_LD(rq, loff, (blk * 16 + t) * RB);
#pragma unroll
        for (int t = 0; t < 16; ++t) {
          unsigned lw = lf[blk * 16 + t]; asm volatile("" : "+v"(lw));
          const float l0 = h2f((u16)(lw & 0xffffu)), l1 = h2f((u16)(lw >> 16));
          c0 += l0; c1 += l1;
          const float q0 = __uint_as_float(lq[t] << 16) * fast_exp(c0 - t0), q1 = __uint_as_float(lq[t] & 0xffff0000u) * fast_exp(c1 - t1);
          const float k0 = (1.f - fast_exp(l0)) * fast_exp(t0 - c0), k1 = (1.f - fast_exp(l1)) * fast_exp(t1 - c1);
          BUF_ST(hw_pk_bf16(q0, q1), rq, loff, (blk * 16 + t) * RB);
          BUF_ST(hw_pk_bf16(k0, k1), rq, loff, (blk * 16 + t) * RB + 2048);
        }
      }
    } else {
      const int j = it - 4096; const int grp = j % 12, bc = j / 12, c = bc & 63;
      const int ch = grp * 128 + 2 * lane;
      const __amdgpu_buffer_rsrc_t rx = BUF_RSRC(p.proj + (size_t)(bc * 64) * kNP + 5120 + grp * 128 - (size_t)3 * kNP);
      const __amdgpu_buffer_rsrc_t rh = BUF_RSRC(p.halo + (size_t)bc * 3 * 1536 + grp * 128);
      float w0[4], w1[4];
#pragma unroll
      for (int q = 0; q < 4; ++q) { w0[q] = p.conv_w[q * 1536 + ch]; w1[q] = p.conv_w[q * 1536 + ch + 1]; }
      const float b0 = p.conv_b[ch], b1 = p.conv_b[ch + 1];
      unsigned raw[67];
#pragma unroll
      for (int t = 0; t < 3; ++t) raw[t] = (c > 0) ? BUF_LD(rx, loff, t * RB) : 0u;
#pragma unroll
      for (int t = 0; t < 64; ++t) raw[3 + t] = BUF_LD(rx, loff, (3 + t) * RB);
      float xa[4], xb[4];
#pragma unroll
      for (int q = 0; q < 3; ++q) { xa[q] = __uint_as_float(raw[q] << 16); xb[q] = __uint_as_float(raw[q] & 0xffff0000u); }
#pragma unroll
      for (int t = 0; t < 64; ++t) {
        unsigned rr = raw[t + 3]; asm volatile("" : "+v"(rr));
        xa[3] = __uint_as_float(rr << 16); xb[3] = __uint_as_float(rr & 0xffff0000u);
        float a0 = b0, a1 = b1;
#pragma unroll
        for (int q = 0; q < 4; ++q) { a0 += w0[q] * xa[q]; a1 += w1[q] * xb[q]; }
#pragma unroll
        for (int q = 0; q < 3; ++q) { xa[q] = xa[q + 1]; xb[q] = xb[q + 1]; }
        const unsigned o = hw_pk_bf16(siluf(a0), siluf(a1));
        if (t < 61) BUF_ST(o, rx, loff, (3 + t) * RB);
        else BUF_ST(o, rh, loff, (t - 61) * 3072);
      }
    }
  }
}

typedef __attribute__((address_space(3))) char LDSC;
typedef __attribute__((address_space(3))) float LDSF;
typedef unsigned u32x4v __attribute__((ext_vector_type(4)));
typedef unsigned u32x2v __attribute__((ext_vector_type(2)));
#define BUF_LD128(rs, voff, soff) __builtin_bit_cast(u32x4v, __builtin_amdgcn_raw_buffer_load_b128((rs), (int)(voff), (int)(soff), 0))
#define BUF_ST128(val, rs, voff, soff) __builtin_amdgcn_raw_buffer_store_b128(__builtin_bit_cast(__attribute__((__vector_size__(4 * sizeof(unsigned)))) unsigned, (val)), (rs), (int)(voff), (int)(soff), 0)
#define LDS_U32X4(ptr) (*(__attribute__((address_space(3))) u32x4v*)(ptr))
#define LDS_U32X2(ptr) (*(__attribute__((address_space(3))) u32x2v*)(ptr))
#define LDS_F32X4(ptr) (*(const __attribute__((address_space(3))) f32x4*)(ptr))
__device__ __forceinline__ bf16x8 lds_frag(const LDSC* base, int row, int col, int stride_el) {
  return *(const __attribute__((address_space(3))) bf16x8*)(base + ((row * stride_el + col) << 1));
}
__device__ __forceinline__ unsigned pk_bf16(float lo, float hi) { return hw_pk_bf16(lo, hi); }
__device__ __forceinline__ float bflo(unsigned u) { return __uint_as_float(u << 16); }
__device__ __forceinline__ float bfhi(unsigned u) { return __uint_as_float(u & 0xffff0000u); }
#define MFMA16(a, b, c) __builtin_amdgcn_mfma_f32_16x16x32_bf16((a), (b), (c), 0, 0, 0)

__device__ void hgrn2_fast(const Params& p, int unit, LDSC* sm) {
  const int b = unit >> 4, hh = (unit >> 1) & 7, vh = unit & 1;
  const int tid = opaque_tid(), lane = tid & 63, w = tid >> 6, fr = lane & 15, fq = lane >> 4;
  constexpr int SQ = 136, SS = 72;
  LDSC* Qp = sm; LDSC* Kh = sm + 17408; LDSC* KhT = sm + 34816; LDSC* vT = sm + 53248; LDSC* att = sm + 62464; LDSC* ST = sm + 71680;
  LDSF* dec = (LDSF*)(sm + 89088);
  const u16* pq = p.proj + (size_t)(b * kL) * kNP + hh * 128;
  const int kp = lane, sg = w, crow = tid >> 3, cseg = (tid & 7) * 16;
  const int vp = lane & 31, vg = w * 2 + (lane >> 5);
  const int tt = w >> 1, vb = (w & 1) * 32;
  const int svt = w & 3, skb = (w >> 2) * 4;
  f32x4 S[4];
#pragma unroll
  for (int i = 0; i < 4; ++i) S[i] = (f32x4){0.f, 0.f, 0.f, 0.f};
  u32x4v cq[2], ck[2]; unsigned tk[8], tv[4]; float dv = 0.f;
  constexpr int RB = kNP * 2;
  const int wu = __builtin_amdgcn_readfirstlane(w);
  const __amdgpu_buffer_rsrc_t rq = BUF_RSRC(pq);
  const __amdgpu_buffer_rsrc_t rd = BUF_RSRC(p.dec + (size_t)(b * 64) * 1024 + hh * 128);
  const __amdgpu_buffer_rsrc_t rm = BUF_RSRC(p.mix + (size_t)(b * kL) * 2048 + hh * 128 + vh * 64);
  const int vo_c = (lane >> 3) * RB + cseg * 2;
  const int vo_k = 2048 + kp * 4;
  const int vo_v = (lane >> 5) * 4 * RB + 4096 + vh * 128 + vp * 4;
  const int vo_o = (tt * 16 + fr) * 4096 + vb * 2 + fq * 16;
  auto load_chunk = [&](int c) {
    const int so = (c * 64 + wu * 8) * RB;
    cq[0] = BUF_LD128(rq, vo_c, so); cq[1] = BUF_LD128(rq, vo_c + 16, so); ck[0] = BUF_LD128(rq, vo_c + 2048, so); ck[1] = BUF_LD128(rq, vo_c + 2064, so);
#pragma unroll
    for (int j = 0; j < 8; ++j) tk[j] = BUF_LD(rq, vo_k, so + j * RB);
#pragma unroll
    for (int j = 0; j < 4; ++j) tv[j] = BUF_LD(rq, vo_v, so + j * RB);
    if (tid < 128) dv = __uint_as_float(BUF_LD(rd, tid * 4, c * 4096));
  };
  load_chunk(0);
  for (int c = 0; c < 64; ++c) {
    LDS_U32X4(Qp + ((crow * SQ + cseg) << 1)) = cq[0]; LDS_U32X4(Qp + ((crow * SQ + cseg + 8) << 1)) = cq[1];
    LDS_U32X4(Kh + ((crow * SQ + cseg) << 1)) = ck[0]; LDS_U32X4(Kh + ((crow * SQ + cseg + 8) << 1)) = ck[1];
    {
      u32x4v a, bq;
#pragma unroll
      for (int i = 0; i < 4; ++i) { a[i] = (tk[2 * i] & 0xffffu) | (tk[2 * i + 1] << 16); bq[i] = (tk[2 * i] >> 16) | (tk[2 * i + 1] & 0xffff0000u); }
      LDS_U32X4(KhT + (((2 * kp) * SS + sg * 8) << 1)) = a; LDS_U32X4(KhT + (((2 * kp + 1) * SS + sg * 8) << 1)) = bq;
      u32x2v x0, x1;
#pragma unroll
      for (int i = 0; i < 2; ++i) { x0[i] = (tv[2 * i] & 0xffffu) | (tv[2 * i + 1] << 16); x1[i] = (tv[2 * i] >> 16) | (tv[2 * i + 1] & 0xffff0000u); }
      LDS_U32X2(vT + (((2 * vp) * SS + vg * 4) << 1)) = x0; LDS_U32X2(vT + (((2 * vp + 1) * SS + vg * 4) << 1)) = x1;
    }
    if (tid < 128) dec[tid] = dv;
    if (c + 1 < 64) load_chunk(c + 1);
    __syncthreads();
#pragma unroll
    for (int i = 0; i < 4; ++i) {
      const int kt = skb + i;
      const f32x4 d = LDS_F32X4(dec + kt * 16 + fq * 4);
      S[i] = S[i] * d;
      LDS_U32X2(ST + (((svt * 16 + fr) * SQ + kt * 16 + fq * 4) << 1)) = (u32x2v){pk_bf16(S[i][0], S[i][1]), pk_bf16(S[i][2], S[i][3])};
    }
    {
      const int st0 = (w & 1) * 2;
      f32x4 a2[2]; a2[0] = (f32x4){0.f, 0.f, 0.f, 0.f}; a2[1] = a2[0];
      if (st0 <= tt) {
        bf16x8 Tq[4], K0[4], K1[4];
#pragma unroll
        for (int ks = 0; ks < 4; ++ks) { Tq[ks] = lds_frag(Qp, tt * 16 + fr, ks * 32 + fq * 8, SQ); K0[ks] = lds_frag(Kh, st0 * 16 + fr, ks * 32 + fq * 8, SQ); }
        if (st0 + 1 <= tt) {
#pragma unroll
          for (int ks = 0; ks < 4; ++ks) K1[ks] = lds_frag(Kh, (st0 + 1) * 16 + fr, ks * 32 + fq * 8, SQ);
          __builtin_amdgcn_sched_barrier(0);
#pragma unroll
          for (int ks = 0; ks < 4; ++ks) { a2[0] = MFMA16(K0[ks], Tq[ks], a2[0]); a2[1] = MFMA16(K1[ks], Tq[ks], a2[1]); }
        } else {
          __builtin_amdgcn_sched_barrier(0);
#pragma unroll
          for (int ks = 0; ks < 4; ++ks) a2[0] = MFMA16(K0[ks], Tq[ks], a2[0]);
        }
      }
      const int t = tt * 16 + fr;
#pragma unroll
      for (int i = 0; i < 2; ++i) { const int s0 = (st0 + i) * 16 + fq * 4;
        LDS_U32X2(att + ((t * SS + s0) << 1)) = (u32x2v){pk_bf16(s0 <= t ? a2[i][0] : 0.f, s0 + 1 <= t ? a2[i][1] : 0.f), pk_bf16(s0 + 2 <= t ? a2[i][2] : 0.f, s0 + 3 <= t ? a2[i][3] : 0.f)}; }
    }
    {
      bf16x8 Bv[2], Ak[2][4];
#pragma unroll
      for (int ks = 0; ks < 2; ++ks) { Bv[ks] = lds_frag(vT, svt * 16 + fr, ks * 32 + fq * 8, SS);
#pragma unroll
        for (int i = 0; i < 4; ++i) Ak[ks][i] = lds_frag(KhT, (skb + i) * 16 + fr, ks * 32 + fq * 8, SS); }
      __builtin_amdgcn_sched_barrier(0);
#pragma unroll
      for (int ks = 0; ks < 2; ++ks)
#pragma unroll
        for (int i = 0; i < 4; ++i) S[i] = MFMA16(Ak[ks][i], Bv[ks], S[i]);
    }
    __syncthreads();
    __builtin_amdgcn_s_setprio(1);
    {
      f32x4 o[2];
#pragma unroll
      for (int i = 0; i < 2; ++i) o[i] = (f32x4){0.f, 0.f, 0.f, 0.f};
      const int vrow = vb + (fr >> 2) * 8 + (fr & 3);
      {
        bf16x8 Tq[4], Vs[4][2], Ta[2], Vv[2][2];
#pragma unroll
        for (int ks = 0; ks < 4; ++ks) { Tq[ks] = lds_frag(Qp, tt * 16 + fr, ks * 32 + fq * 8, SQ);
#pragma unroll
          for (int i = 0; i < 2; ++i) Vs[ks][i] = lds_frag(ST, vrow + i * 4, ks * 32 + fq * 8, SQ); }
#pragma unroll
        for (int ks = 0; ks < 2; ++ks) { Ta[ks] = lds_frag(att, tt * 16 + fr, ks * 32 + fq * 8, SS);
#pragma unroll
          for (int i = 0; i < 2; ++i) Vv[ks][i] = lds_frag(vT, vrow + i * 4, ks * 32 + fq * 8, SS); }
        __builtin_amdgcn_sched_barrier(0);
#pragma unroll
        for (int ks = 0; ks < 4; ++ks)
#pragma unroll
          for (int i = 0; i < 2; ++i) o[i] = MFMA16(Vs[ks][i], Tq[ks], o[i]);
#pragma unroll
        for (int ks = 0; ks < 2; ++ks)
#pragma unroll
          for (int i = 0; i < 2; ++i) o[i] = MFMA16(Vv[ks][i], Ta[ks], o[i]);
      }
      __builtin_amdgcn_s_setprio(0);
      u32x4v ow;
      ow[0] = pk_bf16(o[0][0], o[0][1]); ow[1] = pk_bf16(o[0][2], o[0][3]); ow[2] = pk_bf16(o[1][0], o[1][1]); ow[3] = pk_bf16(o[1][2], o[1][3]);
      BUF_ST128(ow, rm, vo_o, c * 64 * 4096);
    }
    __syncthreads();
  }
}

__device__ void phase_cb(const Params& p) {
  const int tid = opaque_tid(), lane = tid & 63, wid = tid >> 6, fr = lane & 15, fq = lane >> 4;
  const int gw = blockIdx.x * (blockDim.x >> 6) + wid, GW = gridDim.x * (blockDim.x >> 6);
  for (int it2 = gw; it2 < 2048; it2 += GW) {
    const int it = it2 >> 1; const bool hb = (it2 & 1) != 0;
    const int bc = it >> 1, g = it & 1;
    const u16* rowp[4];
#pragma unroll
    for (int q = 0; q < 4; ++q) { const int t = q * 16 + fr;
      rowp[q] = (t < 61) ? p.proj + (size_t)(bc * 64 + t) * kNP + 5120 : p.halo + ((size_t)bc * 3 + (t - 61)) * 1536; }
    f32x4 acc[4][4];
#pragma unroll
    for (int a = 0; a < 4; ++a)
#pragma unroll
      for (int c2 = 0; c2 < 4; ++c2) acc[a][c2] = (f32x4){0.f, 0.f, 0.f, 0.f};
#pragma unroll
    for (int ks = 0; ks < 4; ++ks) {
      bf16x8 Cf[4], Bf[4];
#pragma unroll
      for (int q = 0; q < 4; ++q) { Cf[q] = *(const bf16x8*)(rowp[q] + 1280 + g * 128 + ks * 32 + fq * 8); Bf[q] = *(const bf16x8*)(rowp[q] + 1024 + g * 128 + ks * 32 + fq * 8); }
#pragma unroll
      for (int tt = 0; tt < 4; ++tt)
#pragma unroll
        for (int st = 0; st < 4; ++st) if (st <= tt && (((tt == 1) || (tt == 2)) == hb)) acc[tt][st] = MFMA16(Bf[st], Cf[tt], acc[tt][st]);
    }
    float* dst = p.cbb + (size_t)it * 4096;
#pragma unroll
    for (int tt = 0; tt < 4; ++tt)
#pragma unroll
      for (int st = 0; st < 4; ++st) if (st <= tt && (((tt == 1) || (tt == 2)) == hb)) *(f32x4*)(dst + (tt * 16 + fr) * 64 + st * 16 + fq * 4) = acc[tt][st];
  }
}

__device__ void mamba2_fast(const Params& p, int unit, LDSC* sm) {
  const int b = unit >> 4, hd = unit & 15, g = hd >> 3;
  const int tid = opaque_tid(), lane = tid & 63, w = tid >> 6, fr = lane & 15, fq = lane >> 4;
  constexpr int SQ = 136, SS = 72;
  LDSC* Cc = sm; LDSC* Bc = sm + 17408; LDSC* BdT = sm + 34816; LDSC* xsT = sm + 53248; LDSC* wl = sm + 62464; LDSC* stT = sm + 71680;
  LDSF* csl = (LDSF*)(sm + 89088); LDSF* dtl_s = (LDSF*)(sm + 89344);
  const float A = -fast_exp(p.a_log[hd]), Dk = p.d_skip[hd];
  const int cp = lane, sg = w, crow = tid >> 3, cseg = (tid & 7) * 16;
  const int xp = lane & 31, xg = w * 2 + (lane >> 5);
  const int chB = 1024 + g * 128, chC = 1280 + g * 128, chX = hd * 64;
  auto xrow = [&](int c, int t) -> const u16* {
    return (t < 61) ? p.proj + (size_t)(b * kL + c * 64 + t) * kNP + 5120 : p.halo + ((size_t)(b * 64 + c) * 3 + (t - 61)) * 1536; };
  f32x4 st[4];
#pragma unroll
  for (int i = 0; i < 4; ++i) st[i] = (f32x4){0.f, 0.f, 0.f, 0.f};
  const int tt = w >> 1, pt = w >> 1, pb = (w & 1) * 32;
  u32x4v cC[2]; unsigned tB[8], tX[4]; float dtl; f32x4 cbv[2];
  const int st0 = (w & 1) * 2;
  constexpr int RB = kNP * 2;
  const int wu = __builtin_amdgcn_readfirstlane(w);
  const __amdgpu_buffer_rsrc_t rw = BUF_RSRC(p.proj);
  const __amdgpu_buffer_rsrc_t rm = BUF_RSRC(p.mix + (size_t)(b * kL) * 2048 + 1024 + hd * 64);
  const int oH = (int)((const char*)p.halo - (const char*)p.proj), oD = (int)((const char*)p.dt - (const char*)p.proj), oC = (int)((const char*)p.cbb - (const char*)p.proj);
  auto xoff0 = [&](int t, int ch) -> int { return (t < 61) ? (((b * kL + t) * kNP + 5120 + ch) * 2) : (oH + ((b * 64 * 3 + (t - 61)) * 1536 + ch) * 2); };
  auto xinc = [&](int t) -> int { return (t < 61) ? 64 * RB : 9216; };
  int vC = xoff0(crow, chC + cseg); const int iC = xinc(crow);
  int vX[4], iX[4];
#pragma unroll
  for (int j = 0; j < 4; ++j) { vX[j] = xoff0(xg * 4 + j, chX + 2 * xp); iX[j] = xinc(xg * 4 + j); }
  int vO = xoff0(tt * 16 + fr, chX + pb + fq * 8); const int iO = xinc(tt * 16 + fr);
  const int vo_z = ((tt * 16 + fr) * kNP + 4096 + hd * 64 + pb + fq * 8) * 2;
  const int vo_cb = ((tt * 16 + fr) * 64 + fq * 4) * 4;
  const int vo_o = (tt * 16 + fr) * 4096 + (pb + fq * 8) * 2;
  auto load_chunk = [&](int c) {
    cC[0] = BUF_LD128(rw, vC, 0); cC[1] = BUF_LD128(rw, vC + 16, 0); vC += iC;
    { const int so = oC + ((b * 64 + c) * 2 + g) * 16384;
      cbv[0] = (st0 <= tt) ? __builtin_bit_cast(f32x4, BUF_LD128(rw, vo_cb + st0 * 64, so)) : (f32x4){0.f, 0.f, 0.f, 0.f};
      cbv[1] = (st0 + 1 <= tt) ? __builtin_bit_cast(f32x4, BUF_LD128(rw, vo_cb + (st0 + 1) * 64, so)) : (f32x4){0.f, 0.f, 0.f, 0.f}; }
#pragma unroll
    for (int j = 0; j < 8; ++j) { const int row = wu * 8 + j;
      const int so = (row < 61) ? (((b * kL + c * 64 + row) * kNP + 5120 + chB) * 2) : (oH + (((b * 64 + c) * 3 + (row - 61)) * 1536 + chB) * 2);
      tB[j] = BUF_LD(rw, cp * 4, so); }
#pragma unroll
    for (int j = 0; j < 4; ++j) { tX[j] = BUF_LD(rw, vX[j], 0); vX[j] += iX[j]; }
    dtl = __uint_as_float(BUF_LD(rw, lane * 64 + hd * 4, oD + (b * kL + c * 64) * 64));
  };
  load_chunk(0);
  const int sgu = __builtin_amdgcn_readfirstlane(w);
  float n_dt, n_cs, n_cl, n_scl;
  auto scan_next = [&]() {
    n_dt = dtl; float cs = n_dt * A;
#pragma unroll
    for (int o2 = 1; o2 < 64; o2 <<= 1) { const float up = __shfl_up(cs, o2); if (lane >= o2) cs += up; }
    n_cs = cs; n_cl = __shfl(cs, 63); n_scl = fast_exp(n_cl - cs) * n_dt;
  };
  scan_next();
  for (int c = 0; c < 64; ++c) {
    const float dtc = n_dt, cs = n_cs, cs_last = n_cl, scl = n_scl;
    const f32x4 cb0 = cbv[0], cb1 = cbv[1];
    if (w == 0) { csl[lane] = cs; dtl_s[lane] = dtc; }
    LDS_U32X4(Cc + ((crow * SQ + cseg) << 1)) = cC[0]; LDS_U32X4(Cc + ((crow * SQ + cseg + 8) << 1)) = cC[1];
    {
      u32x4v d0, d1;
#pragma unroll
      for (int i = 0; i < 4; ++i) {
        const float s0 = __int_as_float(__builtin_amdgcn_readlane(__float_as_int(scl), sgu * 8 + 2 * i)), s1 = __int_as_float(__builtin_amdgcn_readlane(__float_as_int(scl), sgu * 8 + 2 * i + 1));
        d0[i] = pk_bf16(bflo(tB[2 * i]) * s0, bflo(tB[2 * i + 1]) * s1); d1[i] = pk_bf16(bfhi(tB[2 * i]) * s0, bfhi(tB[2 * i + 1]) * s1); }
      LDS_U32X4(BdT + (((2 * cp) * SS + sg * 8) << 1)) = d0; LDS_U32X4(BdT + (((2 * cp + 1) * SS + sg * 8) << 1)) = d1;
      u32x2v x0, x1;
#pragma unroll
      for (int i = 0; i < 2; ++i) { x0[i] = (tX[2 * i] & 0xffffu) | (tX[2 * i + 1] << 16); x1[i] = (tX[2 * i] >> 16) | (tX[2 * i + 1] & 0xffff0000u); }
      LDS_U32X2(xsT + (((2 * xp) * SS + xg * 4) << 1)) = x0; LDS_U32X2(xsT + (((2 * xp + 1) * SS + xg * 4) << 1)) = x1;
    }
    const u32x4v zg = BUF_LD128(rw, vo_z, (b * kL + c * 64) * RB);
    const u32x4v xo = BUF_LD128(rw, vO, 0); vO += iO;
    if (c + 1 < 64) load_chunk(c + 1);
    __syncthreads();
#pragma unroll
    for (int i = 0; i < 4; ++i) { const int nt = (w & 1) * 4 + i;
      LDS_U32X2(stT + (((pt * 16 + fr) * SQ + nt * 16 + fq * 4) << 1)) = (u32x2v){pk_bf16(st[i][0], st[i][1]), pk_bf16(st[i][2], st[i][3])}; }
    const float cst = __shfl(cs, tt * 16 + fr);
    {
      const f32x4 a2[2] = {cb0, cb1};
      const int t = tt * 16 + fr;
#pragma unroll
      for (int i = 0; i < 2; ++i) { const int s0 = (st0 + i) * 16 + fq * 4;
        const f32x4 css = LDS_F32X4(csl + s0), dts = LDS_F32X4(dtl_s + s0);
        float wv[4];
#pragma unroll
        for (int r = 0; r < 4; ++r) wv[r] = (s0 + r <= t) ? a2[i][r] * fast_exp(cst - css[r]) * dts[r] : 0.f;
        LDS_U32X2(wl + ((t * SS + s0) << 1)) = (u32x2v){pk_bf16(wv[0], wv[1]), pk_bf16(wv[2], wv[3])}; }
    }
    {
      const float dk = fast_exp(cs_last);
#pragma unroll
      for (int i = 0; i < 4; ++i) st[i] = st[i] * dk;
#pragma unroll
      for (int ks = 0; ks < 1; ++ks) {
        bf16x8 Bf[2], Af[2][4];
#pragma unroll
        for (int k2 = 0; k2 < 2; ++k2) { Bf[k2] = lds_frag(xsT, pt * 16 + fr, k2 * 32 + fq * 8, SS);
#pragma unroll
          for (int i = 0; i < 4; ++i) Af[k2][i] = lds_frag(BdT, ((w & 1) * 4 + i) * 16 + fr, k2 * 32 + fq * 8, SS); }
        __builtin_amdgcn_sched_barrier(0);
#pragma unroll
        for (int k2 = 0; k2 < 2; ++k2)
#pragma unroll
          for (int i = 0; i < 4; ++i) st[i] = MFMA16(Af[k2][i], Bf[k2], st[i]);
      }
    }
    __syncthreads();
    __builtin_amdgcn_s_setprio(1);
    {
      f32x4 yo[2], yd[2];
#pragma unroll
      for (int i = 0; i < 2; ++i) { yo[i] = (f32x4){0.f, 0.f, 0.f, 0.f}; yd[i] = yo[i]; }
      const int prow = pb + (fr >> 2) * 8 + (fr & 3);
      {
        bf16x8 Tc[4], Ps[4][2], Tw[2], Px[2][2];
#pragma unroll
        for (int ks = 0; ks < 4; ++ks) { Tc[ks] = lds_frag(Cc, tt * 16 + fr, ks * 32 + fq * 8, SQ);
#pragma unroll
          for (int i = 0; i < 2; ++i) Ps[ks][i] = lds_frag(stT, prow + i * 4, ks * 32 + fq * 8, SQ); }
#pragma unroll
        for (int ks = 0; ks < 2; ++ks) { Tw[ks] = lds_frag(wl, tt * 16 + fr, ks * 32 + fq * 8, SS);
#pragma unroll
          for (int i = 0; i < 2; ++i) Px[ks][i] = lds_frag(xsT, prow + i * 4, ks * 32 + fq * 8, SS); }
        __builtin_amdgcn_sched_barrier(0);
#pragma unroll
        for (int ks = 0; ks < 4; ++ks)
#pragma unroll
          for (int i = 0; i < 2; ++i) yo[i] = MFMA16(Ps[ks][i], Tc[ks], yo[i]);
#pragma unroll
        for (int ks = 0; ks < 2; ++ks)
#pragma unroll
          for (int i = 0; i < 2; ++i) yd[i] = MFMA16(Px[ks][i], Tw[ks], yd[i]);
      }
      __builtin_amdgcn_s_setprio(0);
      const float ec = fast_exp(cst);
      const unsigned zw[4] = {zg.x, zg.y, zg.z, zg.w}, xw[4] = {xo.x, xo.y, xo.z, xo.w};
      u32x4v ow;
#pragma unroll
      for (int i = 0; i < 2; ++i) {
        ow[2 * i] = pk_bf16((yd[i][0] + ec * yo[i][0] + Dk * bflo(xw[2 * i])) * bflo(zw[2 * i]), (yd[i][1] + ec * yo[i][1] + Dk * bfhi(xw[2 * i])) * bfhi(zw[2 * i]));
        ow[2 * i + 1] = pk_bf16((yd[i][2] + ec * yo[i][2] + Dk * bflo(xw[2 * i + 1])) * bflo(zw[2 * i + 1]), (yd[i][3] + ec * yo[i][3] + Dk * bfhi(xw[2 * i + 1])) * bfhi(zw[2 * i + 1])); }
      BUF_ST128(ow, rm, vo_o, c * 64 * 4096);
    }
    if (c + 1 < 64) scan_next();
    __syncthreads();
  }
}

__device__ void phase_postnorm(const Params& p) {
  const int tid = opaque_tid(), lane = tid & 63, wid = tid >> 6;
  const int gw = blockIdx.x * (blockDim.x >> 6) + wid, GW = gridDim.x * (blockDim.x >> 6);
  for (int row0 = gw * 2; row0 < kT; row0 += GW * 2) {
    u32x4v raw[2][4], gg[2][2];
#pragma unroll
    for (int r = 0; r < 2; ++r) {
      const u16* mr = p.mix + (size_t)(row0 + r) * 2048 + lane * 8;
#pragma unroll
      for (int q = 0; q < 4; ++q) raw[r][q] = *(const u32x4v*)(mr + q * 512);
      const u16* gr = p.proj + (size_t)(row0 + r) * kNP + 3072 + lane * 8;
      gg[r][0] = __builtin_nontemporal_load((const u32x4v*)gr); gg[r][1] = __builtin_nontemporal_load((const u32x4v*)(gr + 512));
    }
#pragma unroll
    for (int r = 0; r < 2; ++r) {
      u16* mr = p.mix + (size_t)(row0 + r) * 2048 + lane * 8;
#pragma unroll
      for (int q = 0; q < 4; ++q) {
        float v[8]; float ss = 0.f;
#pragma unroll
        for (int i = 0; i < 4; ++i) { v[2 * i] = bflo(raw[r][q][i]); v[2 * i + 1] = bfhi(raw[r][q][i]); ss += v[2 * i] * v[2 * i] + v[2 * i + 1] * v[2 * i + 1]; }
        u32x4v ow;
        if (q < 2) {
          ss += __shfl_xor(ss, 1); ss += __shfl_xor(ss, 2); ss += __shfl_xor(ss, 4); ss += __shfl_xor(ss, 8);
          const float rs = rsqrtf(ss * (1.f / 128.f) + kEps);
          const float* nw = p.hg_nw + q * 512 + lane * 8;
#pragma unroll
          for (int i = 0; i < 4; ++i) ow[i] = hw_pk_bf16(v[2 * i] * rs * nw[2 * i] * bflo(gg[r][q][i]), v[2 * i + 1] * rs * nw[2 * i + 1] * bfhi(gg[r][q][i]));
        } else {
          ss = wave_sum(ss);
          const float rs = rsqrtf(ss * (1.f / 512.f) + kEps);
          const float* nw = p.m2_nw + (q - 2) * 512 + lane * 8;
#pragma unroll
          for (int i = 0; i < 4; ++i) ow[i] = hw_pk_bf16(v[2 * i] * rs * nw[2 * i], v[2 * i + 1] * rs * nw[2 * i + 1]);
        }
        *(u32x4v*)(mr + q * 512) = ow;
      }
    }
  }
}

__device__ void phase_final(const Params& p) {
  const int tid = opaque_tid(), lane = tid & 63, wid = tid >> 6;
  const int gw = blockIdx.x * (blockDim.x >> 6) + wid, GW = gridDim.x * (blockDim.x >> 6);
  for (int row0 = gw * 4; row0 < kT; row0 += GW * 4) {
    float4 v[4][4]; float ss[4];
#pragma unroll
    for (int r = 0; r < 4; ++r) { const float4* xr = (const float4*)(p.xres + (size_t)(row0 + r) * 1024);
#pragma unroll
      for (int i = 0; i < 4; ++i) v[r][i] = xr[i * 64 + lane]; }
#pragma unroll
    for (int r = 0; r < 4; ++r) { float a = 0.f;
#pragma unroll
      for (int i = 0; i < 4; ++i) a += v[r][i].x * v[r][i].x + v[r][i].y * v[r][i].y + v[r][i].z * v[r][i].z + v[r][i].w * v[r][i].w;
      ss[r] = wave_sum(a); }
#pragma unroll
    for (int i = 0; i < 4; ++i) { const float4 w = ((const float4*)p.fin_w)[i * 64 + lane];
#pragma unroll
      for (int r = 0; r < 4; ++r) { const float rs = rsqrtf(ss[r] * (1.f / 1024.f) + kEps);
        float4 o; o.x = v[r][i].x * rs * w.x; o.y = v[r][i].y * rs * w.y; o.z = v[r][i].z * rs * w.z; o.w = v[r][i].w * rs * w.w;
        ((float4*)(p.out + (size_t)(row0 + r) * 1024))[i * 64 + lane] = o; } }
  }
}

#define XB_TMO      128
#define XB_XCNT(j)  (256  + 64 * (j))
#define XB_XSUB(j)  (1280 + 64 * (j))
#define XB_XGEN(j)  (2304 + 64 * (j))
#define XB_TOP      3328
#define XB_TOPGEN   3392
#define XCD_BAR_WORDS 3456
#define XB_SPIN_CAP (1u << 18)
#define LAS __attribute__((address_space(3)))

__device__ __forceinline__ unsigned xb_ld(unsigned* p)              { return __hip_atomic_load(p, __ATOMIC_RELAXED, __HIP_MEMORY_SCOPE_AGENT); }
__device__ __forceinline__ unsigned xb_add(unsigned* p, unsigned v) { return __hip_atomic_fetch_add(p, v, __ATOMIC_RELAXED, __HIP_MEMORY_SCOPE_AGENT); }
__device__ __forceinline__ unsigned xb_xcc_id() { return (unsigned)__builtin_amdgcn_s_getreg((3 << 11) | 20) & 0xFu; }
#define XB_SPIN(cond, bar) do { unsigned _sp = 0; while (cond) { __builtin_amdgcn_s_sleep(1); \
    if ((++_sp & 255u) == 0u) { if (xb_ld(&(bar)[XB_TMO])) break; if (_sp > XB_SPIN_CAP) { atomicAdd(&(bar)[XB_TMO], 1u); break; } } } } while (0)

struct XcdBarrier {
    unsigned* bar; unsigned x;
    volatile LAS unsigned* st;
};

__device__ __forceinline__ XcdBarrier xcd_barrier_post(unsigned* bar, volatile LAS unsigned* st) {
    XcdBarrier b; b.bar = bar; b.x = xb_xcc_id(); b.st = st;
    if (threadIdx.x == 0) (void)xb_add(&bar[XB_XCNT(b.x)], 1u);
    return b;
}
__device__ __forceinline__ void xcd_barrier_complete(unsigned* bar, unsigned x, unsigned& nloc, unsigned& nx) {
    const unsigned G = gridDim.x * gridDim.y * gridDim.z;
    unsigned sum, cnt, mine, sp = 0u;
    for (;;) {
        sum = 0u; cnt = 0u; mine = 0u;
#pragma unroll
        for (unsigned j = 0; j < 16; ++j) { const unsigned c = xb_ld(&bar[XB_XCNT(j)]); sum += c; cnt += (c > 0u) ? 1u : 0u; mine = (j == x) ? c : mine; }
        if (sum == G) break;
        __builtin_amdgcn_s_sleep(1);
        if ((++sp & 255u) == 0u) { if (xb_ld(&bar[XB_TMO])) break; if (sp > XB_SPIN_CAP) { atomicAdd(&bar[XB_TMO], 1u); break; } }
    }
    nloc = mine > 0u ? mine : 1u; nx = cnt > 0u ? cnt : 1u;
}

__device__ __forceinline__ void xcd_barrier(const XcdBarrier& b) {
    asm volatile("s_waitcnt vmcnt(0)" ::: "memory");
    __syncthreads();
    if (threadIdx.x == 0) {
        unsigned* bar = b.bar;
        __builtin_amdgcn_s_waitcnt(0);
        unsigned nloc = b.st[0], nx = b.st[1];
        if (nloc == 0u) { xcd_barrier_complete(bar, b.x, nloc, nx); b.st[0] = nloc; b.st[1] = nx; }
        const unsigned old = xb_add(&bar[XB_XSUB(b.x)], 1u);
        const unsigned gen = old / nloc;
        if (old + 1u == (gen + 1u) * nloc) {
            __builtin_amdgcn_fence(__ATOMIC_RELEASE, "agent");
            asm volatile("s_waitcnt vmcnt(0)" ::: "memory");
            const unsigned og = xb_add(&bar[XB_TOP], 1u);
            const unsigned tg = og / nx;
            if (og + 1u == (tg + 1u) * nx) xb_add(&bar[XB_TOPGEN], 1u);
            else XB_SPIN(xb_ld(&bar[XB_TOPGEN]) == tg, bar);
            __builtin_amdgcn_fence(__ATOMIC_ACQUIRE, "agent");
            xb_add(&bar[XB_XGEN(b.x)], 1u);
            asm volatile("s_waitcnt vmcnt(0)" ::: "memory");
        } else {
            XB_SPIN(xb_ld(&bar[XB_XGEN(b.x)]) == gen, bar);
            __builtin_amdgcn_fence(__ATOMIC_ACQUIRE, "agent");
            asm volatile("s_waitcnt vmcnt(0)" ::: "memory");
        }
    }
    __syncthreads();
}


extern __shared__ __attribute__((aligned(16))) char g_smem[];
constexpr int kThreads = 512;
constexpr size_t kDynLds = 131072 + 16;
__global__ void __launch_bounds__(kThreads, 2) k_mega(Params p) {
  cg::grid_group grid = cg::this_grid();
  volatile LAS unsigned* xst = (volatile LAS unsigned*)((LDSC*)g_smem + 131072);
  if (threadIdx.x < 4) xst[threadIdx.x] = 0u;
  __syncthreads();
  const XcdBarrier xb = xcd_barrier_post(p.bar, xst);
  phase_prep(p, g_smem);
  if (p.use_cg_sync) grid.sync();
  xcd_barrier(xb);
  { Epi1F e{p.proj, p.lb}; pg8::StaticOrder S; S.init(kT, kNP, (int)gridDim.x, (int)blockIdx.x);
    pg8::gemm_phase<Epi1F, pg8::StaticOrder, false>((PG8_LAS unsigned char*)g_smem, pg8::Gemm{p.h, p.Wt1, kT, kNP, 1024}, S, e, nullptr);
    phase_dt(p); }
  xcd_barrier(xb);
  phase_premix(p);
  xcd_barrier(xb);
  phase_cb(p);
  xcd_barrier(xb);
  for (int u = blockIdx.x; u < 256; u += gridDim.x) {
    const int xcd = u & 7, slot = u >> 3;
    if (slot < 16) { const int G = xcd * 2 + (slot >> 3); mamba2_fast(p, (G >> 1) * 16 + (G & 1) * 8 + (slot & 7), (LDSC*)g_smem); }
    else { const int pair = xcd * 8 + ((slot - 16) >> 1); hgrn2_fast(p, pair * 2 + (slot & 1), (LDSC*)g_smem); }
    __syncthreads();
  }
  xcd_barrier(xb);
  phase_postnorm(p);
  xcd_barrier(xb);
  if (gridDim.x == 256) {
    Epi2N e{p.out, p.x, p.fin_w, p.rowss, p.pcnt}; pg8::StaticOrder S; S.init(kT, 1024, (int)gridDim.x, (int)blockIdx.x);
    pg8::gemm_phase<Epi2N, pg8::StaticOrder, false>((PG8_LAS unsigned char*)g_smem, pg8::Gemm{p.mix, p.Wt2, kT, 1024, 2048}, S, e, nullptr);
  } else {
    { Epi2F e{p.xres, p.x}; pg8::StaticOrder S; S.init(kT, 1024, (int)gridDim.x, (int)blockIdx.x);
      pg8::gemm_phase<Epi2F, pg8::StaticOrder, false>((PG8_LAS unsigned char*)g_smem, pg8::Gemm{p.mix, p.Wt2, kT, 1024, 2048}, S, e, nullptr); }
    xcd_barrier(xb);
    phase_final(p);
  }
}

extern "C" void kernel_launch(void* const* d_in, const int* in_sizes, int n_in, void* d_out, int out_size, void* d_ws, size_t ws_size, hipStream_t stream) {
  Params p{};
  p.x = (const float*)d_in[0]; p.norm_w = (const float*)d_in[1]; p.w_in = (const float*)d_in[2]; p.lb_logits = (const float*)d_in[3];
  p.hg_nw = (const float*)d_in[4]; p.conv_w = (const float*)d_in[5]; p.conv_b = (const float*)d_in[6]; p.dt_bias = (const float*)d_in[7];
  p.a_log = (const float*)d_in[8]; p.d_skip = (const float*)d_in[9]; p.m2_nw = (const float*)d_in[10]; p.w_out = (const float*)d_in[11];
  p.fin_w = (const float*)d_in[12];
  p.out = (float*)d_out;
  char* ws = (char*)d_ws; size_t off = 0;
  auto take = [&](size_t bytes) { char* r = ws + off; off += (bytes + 255) & ~(size_t)255; return r; };
  p.proj = (u16*)take((size_t)kT * kNP * 2);
  p.xres = (float*)p.proj;
  p.Wt1 = (u16*)take((size_t)kNIN * 1024 * 2);
  p.Wt2 = (u16*)take((size_t)1024 * 2048 * 2);
  p.dt = (float*)take((size_t)kT * 16 * 4);
  p.lb = (float*)take(1024 * 4);
  p.dec = (float*)take((size_t)8 * 64 * 1024 * 4);
  p.halo = (u16*)take((size_t)8 * 64 * 3 * 1536 * 2);
  p.bar = (unsigned*)take((size_t)XCD_BAR_WORDS * 4);
  p.rowss = (float*)take((size_t)kT * 4);
  p.pcnt = (unsigned*)take(1024);
  p.cbb = (float*)take((size_t)1024 * 4096 * 4);
  p.h = (u16*)d_out;
  p.mix = (u16*)d_out;
  if (off > ws_size) { fprintf(stderr, "workspace too small: need %zu have %zu\n", off, ws_size); return; }
  static int grid_blocks = 0;
  if (!grid_blocks) {
    int dev = 0, cus = 0, per_cu = 0;
    hipGetDevice(&dev);
    hipFuncSetAttribute((const void*)k_mega, hipFuncAttributeMaxDynamicSharedMemorySize, (int)kDynLds);
    hipDeviceGetAttribute(&cus, hipDeviceAttributeMultiprocessorCount, dev);
    hipOccupancyMaxActiveBlocksPerMultiprocessor(&per_cu, k_mega, kThreads, kDynLds);
    if (per_cu > 2) per_cu = 2;
    grid_blocks = cus * per_cu;
  }
  (void)hipMemsetAsync(p.bar, 0, (size_t)XCD_BAR_WORDS * 4 + (size_t)kT * 4 + 1024, stream);
  void* args[] = {&p};
  hipError_t e = hipLaunchCooperativeKernel((void*)k_mega, dim3(grid_blocks), dim3(kThreads), args, kDynLds, stream);
  if (e != hipSuccess) fprintf(stderr, "cooperative launch failed: %s (grid %d)\n", hipGetErrorString(e), grid_blocks);
}
```
